# Optimizing an MI355X kernel written in HIP

```python
import jax, jax.numpy as jnp
from jax import lax
import numpy as np

D_MODEL = 2048
BATCH = 1
SEQ = 8192
DEPTH = 2

POOL_WIDTH = D_MODEL // 2
POOL_WINDOWS = (2, 4, 8, 16)
N_POOL_GROUPS = len(POOL_WINDOWS)
POOL_GROUP = POOL_WIDTH // N_POOL_GROUPS
ATTN_WIDTH = D_MODEL - POOL_WIDTH
HEAD_DIM = 128
N_HEADS = ATTN_WIDTH // HEAD_DIM
DILATED_PATTERNS = ((128, 1), (512, 4), (2048, 16))
IN_WIDTH = POOL_WIDTH + 3 * ATTN_WIDTH
D_FF = 5632
ROPE_THETA = 10000.0
EPS = 1e-6
Q_BLOCK = 128
NEG = -1e30

kernel_name = "hybrid_pool_dilated_attn_macaron"


def rmsnorm(x, g):
    xf = x.astype(jnp.float32)
    y = xf * lax.rsqrt(jnp.mean(xf * xf, axis=-1, keepdims=True) + EPS)
    return (y * g.astype(jnp.float32)).astype(x.dtype)


def swiglu(h, w_gate, w_up, w_down):
    return (jax.nn.silu(h @ w_gate) * (h @ w_up)) @ w_down


def rope(x, cos, sin):
    xf = x.astype(jnp.float32)
    x1, x2 = jnp.split(xf, 2, axis=-1)
    c = cos[None, :, None, :]
    s = sin[None, :, None, :]
    return jnp.concatenate([x1 * c - x2 * s, x2 * c + x1 * s], axis=-1).astype(x.dtype)


def pool_mixer(u, pool_w, pool_scale):
    B, S, C = u.shape
    uf = u.astype(jnp.float32)
    cs = jnp.concatenate([jnp.zeros((B, 1, C), jnp.float32), jnp.cumsum(uf, axis=1)], axis=1)
    pos = jnp.arange(S)
    groups = []
    for g, w in enumerate(POOL_WINDOWS):
        lo = jnp.clip(pos - w // 2, 0, S)
        hi = jnp.clip(pos + w // 2, 0, S)
        cnt = (hi - lo).astype(jnp.float32)[None, :, None]
        csg = cs[:, :, g * POOL_GROUP:(g + 1) * POOL_GROUP]
        mean = (jnp.take(csg, hi, axis=1) - jnp.take(csg, lo, axis=1)) / cnt
        groups.append(mean - uf[:, :, g * POOL_GROUP:(g + 1) * POOL_GROUP])
    pooled = jnp.stack(groups, axis=2)
    mixed = jnp.einsum('bsgc,gcd->bsgd', pooled, pool_w.astype(jnp.float32))
    out = mixed.reshape(B, S, C) * pool_scale.astype(jnp.float32)
    return out.astype(u.dtype)


def dilated_attention(q, k, v):
    B, S, H, Dh = q.shape
    n_blocks = S // Q_BLOCK
    scale = Dh ** -0.5
    offsets = [d * jnp.arange(-(w // 2) // d, (w // 2) // d + 1) for (w, d) in DILATED_PATTERNS]

    def block(start):
        qpos = start + jnp.arange(Q_BLOCK)
        qb = lax.dynamic_slice_in_dim(q, start, Q_BLOCK, axis=1)
        lses, outs = [], []
        for off in offsets:
            kpos = qpos[:, None] + off[None, :]
            valid = (kpos >= 0) & (kpos < S)
            idx = jnp.clip(kpos, 0, S - 1)
            kg = k[:, idx]
            vg = v[:, idx]
            s = jnp.einsum('bqhd,bqkhd->bhqk', qb, kg,
                           preferred_element_type=jnp.float32) * scale
            s = jnp.where(valid[None, None], s, NEG)
            lse = jax.nn.logsumexp(s, axis=-1)
            p = jnp.exp(s - lse[..., None])
            o = jnp.einsum('bhqk,bqkhd->bqhd', p, vg.astype(jnp.float32))
            lses.append(lse)
            outs.append(o)
        wts = jax.nn.softmax(jnp.stack(lses, axis=0), axis=0)
        wts = jnp.transpose(wts, (0, 1, 3, 2))[..., None]
        return jnp.sum(wts * jnp.stack(outs, axis=0), axis=0).astype(q.dtype)

    out = lax.map(block, jnp.arange(n_blocks) * Q_BLOCK)
    return jnp.transpose(out, (1, 0, 2, 3, 4)).reshape(B, S, H, Dh)


def hybrid_mixer(h, w_in, q_gain, k_gain, pool_w, pool_scale, w_out, cos, sin):
    B, S, _ = h.shape
    proj = h @ w_in
    u = proj[..., :POOL_WIDTH]
    q, k, v = jnp.split(proj[..., POOL_WIDTH:], 3, axis=-1)
    q = q.reshape(B, S, N_HEADS, HEAD_DIM)
    k = k.reshape(B, S, N_HEADS, HEAD_DIM)
    v = v.reshape(B, S, N_HEADS, HEAD_DIM)
    q = rope(rmsnorm(q, q_gain), cos, sin)
    k = rope(rmsnorm(k, k_gain), cos, sin)
    a_out = dilated_attention(q, k, v).reshape(B, S, ATTN_WIDTH)
    p_out = pool_mixer(u, pool_w, pool_scale)
    return jnp.concatenate([p_out, a_out.astype(h.dtype)], axis=-1) @ w_out


def setup_inputs(seed: int = 0) -> dict:
    key = jax.random.key(seed)
    ks = jax.random.split(key, 20)
    f32 = jnp.float32

    def w(k, shape, fan_in):
        return jax.random.normal(k, shape, f32) * fan_in ** -0.5

    def gain(k, shape):
        return 1.0 + 0.05 * jax.random.normal(k, shape, f32)

    return {
        "x": jax.random.normal(ks[0], (BATCH, SEQ, D_MODEL), f32),
        "norm_ffn1": gain(ks[1], (DEPTH, D_MODEL)),
        "ffn1_w_gate": w(ks[2], (DEPTH, D_MODEL, D_FF), D_MODEL),
        "ffn1_w_up": w(ks[3], (DEPTH, D_MODEL, D_FF), D_MODEL),
        "ffn1_w_down": w(ks[4], (DEPTH, D_FF, D_MODEL), D_FF),
        "norm_mix": gain(ks[5], (DEPTH, D_MODEL)),
        "w_in": w(ks[6], (DEPTH, D_MODEL, IN_WIDTH), D_MODEL),
        "q_norm": gain(ks[7], (DEPTH, HEAD_DIM)),
        "k_norm": gain(ks[8], (DEPTH, HEAD_DIM)),
        "pool_w": w(ks[9], (DEPTH, N_POOL_GROUPS, POOL_GROUP, POOL_GROUP), POOL_GROUP),
        "pool_scale": 1.0 + 0.1 * jax.random.normal(ks[10], (DEPTH, POOL_WIDTH), f32),
        "w_out": w(ks[11], (DEPTH, D_MODEL, D_MODEL), D_MODEL),
        "norm_ffn2": gain(ks[12], (DEPTH, D_MODEL)),
        "ffn2_w_gate": w(ks[13], (DEPTH, D_MODEL, D_FF), D_MODEL),
        "ffn2_w_up": w(ks[14], (DEPTH, D_MODEL, D_FF), D_MODEL),
        "ffn2_w_down": w(ks[15], (DEPTH, D_FF, D_MODEL), D_FF),
    }


def reference(x, norm_ffn1, ffn1_w_gate, ffn1_w_up, ffn1_w_down, norm_mix, w_in,
              q_norm, k_norm, pool_w, pool_scale, w_out, norm_ffn2, ffn2_w_gate,
              ffn2_w_up, ffn2_w_down):
    S = x.shape[1]
    inv_freq = ROPE_THETA ** (-jnp.arange(0, HEAD_DIM, 2, dtype=jnp.float32) / HEAD_DIM)
    ang = jnp.arange(S, dtype=jnp.float32)[:, None] * inv_freq[None, :]
    cos, sin = jnp.cos(ang), jnp.sin(ang)
    for l in range(DEPTH):
        h = rmsnorm(x, norm_ffn1[l])
        x = x + (0.5 * swiglu(h, ffn1_w_gate[l], ffn1_w_up[l], ffn1_w_down[l])).astype(x.dtype)
        h = rmsnorm(x, norm_mix[l])
        x = x + hybrid_mixer(h, w_in[l], q_norm[l], k_norm[l], pool_w[l], pool_scale[l],
                             w_out[l], cos, sin).astype(x.dtype)
        h = rmsnorm(x, norm_ffn2[l])
        x = x + (0.5 * swiglu(h, ffn2_w_gate[l], ffn2_w_up[l], ffn2_w_down[l])).astype(x.dtype)
    return x
```

```cpp
#include <hip/hip_runtime.h>
#include <hip/hip_cooperative_groups.h>
#include <cstdio>
#include <cstdint>
namespace cg = cooperative_groups;
namespace pg8 {
#define PG8_LAS __attribute__((address_space(3)))
typedef unsigned short bf16_t;
typedef short bf16x8 __attribute__((ext_vector_type(8)));
typedef float f32x4 __attribute__((ext_vector_type(4)));
typedef unsigned u32x4 __attribute__((ext_vector_type(4)));
typedef unsigned u32x2 __attribute__((ext_vector_type(2)));
constexpr int BM = 256, BK = 64, HALF = 128, HTB = HALF * BK * 2  , STAGE_BYTES = 8 * HTB, NXCD = 8, WGM = 8;

__host__ __device__ __forceinline__ int lds_byte(int r, int c) { const int st = (r >> 4) * 2 + (c >> 5), rr = r & 15, cc = c & 31, ob = rr * 64 + cc * 2; return st * 1024 + (ob ^ (((ob >> 9) & 1) << 5)); }
__host__ __device__ __forceinline__ void stage_rc(int b, int& R, int& C) { const int st = b / 1024, sb = b % 1024, swz = sb ^ (((sb >> 9) & 1) << 5); R = (st >> 1) * 16 + swz / 64; C = (st & 1) * 32 + (swz % 64) / 2; }
__host__ __device__ __forceinline__ int perm32(int rho) { const int n = rho >> 4, i = rho & 15; return 8 * (i >> 2) + 4 * n + (i & 3); }

struct Unit { int pm, pn; };
struct Gemm { const bf16_t* A; const bf16_t* Bt; int M, N, K; };

struct StaticOrder {
    int nM, nN, nwg, G, c;
    __host__ __device__ void init(int M, int N, int G_, int c_) { nM = M / BM; nN = N / BM; nwg = nM * nN; G = G_; c = c_; }
    __host__ __device__ bool next(int i, Unit& u) const {
        const long L = (long)i * G + c; if (L >= nwg) return false;
        int wgid = (int)L; { const int q = nwg / NXCD, r = nwg % NXCD, xcd = wgid % NXCD, off = wgid / NXCD; wgid = (xcd < r ? xcd * (q + 1) : r * (q + 1) + (xcd - r) * q) + off; }
        const int nig = WGM * nN, gid = wgid / nig, fm = gid * WGM, gsz = (nM - fm) < WGM ? (nM - fm) : WGM;
        u.pm = fm + ((wgid % nig) % gsz); u.pn = (wgid % nig) / gsz; return true;
    }
    __device__ __forceinline__ void a_ready(const Unit&) const {}
    __device__ __forceinline__ void done(const Unit&) const {}
};

struct MiniOrder {
    int nN, n, c;
    __host__ __device__ void init(int nM_, int nN_, int c0, int c_) { nN = nN_; n = nM_ * nN_; c = c_ - c0; }
    __host__ __device__ bool next(int i, Unit& u) const { if (i != 0 || c < 0 || c >= n) return false; u.pm = c / nN; u.pn = c - u.pm * nN; return true; }
    __device__ __forceinline__ void a_ready(const Unit&) const {}
    __device__ __forceinline__ void done(const Unit&) const {}
};

__device__ __forceinline__ unsigned cvt_pk_bf16(float lo, float hi) { unsigned r; asm volatile("v_cvt_pk_bf16_f32 %0, %1, %2" : "=v"(r) : "v"(lo), "v"(hi)); return r; }

constexpr float EPS = 1e-6f;
typedef unsigned long long u64;
__device__ __forceinline__ void ssq_add(u64* p, float v) { atomicAdd(p, (u64)(v * 1048576.0f + 0.5f)); }
__device__ __forceinline__ float ssq_get(const u64* p) { return (float)(*p) * (1.0f / 1048576.0f); }
__device__ __forceinline__ float part8(const float* p) { const f32x4 a = *(const f32x4*)p, b = *(const f32x4*)(p + 4); return ((a[0] + a[1]) + (a[2] + a[3])) + ((b[0] + b[1]) + (b[2] + b[3])); }


struct EpiBf16 {
    static constexpr bool PERM = true, AFTER_DRAIN = false, HAS_INIT = false, HAS_ACC_INIT = false, HAS_XT = false;
    bf16_t* O; int ldc;
    __device__ __forceinline__ void operator()(const f32x4 (&acc)[2][2][4][2], const Unit& u, int wr, int wc, int fr, int fq) const {
        const int row0 = u.pm * BM + wr * 64 + fr, col0 = u.pn * BM + wc * 32 + 8 * fq;
#pragma unroll
        for (int ai = 0; ai < 2; ++ai)
#pragma unroll
            for (int m = 0; m < 4; ++m) { bf16_t* rowp = O + (size_t)(row0 + ai * HALF + m * 16) * ldc + col0;
#pragma unroll
                for (int bj = 0; bj < 2; ++bj) { const f32x4 v0 = acc[ai][bj][m][0], v1 = acc[ai][bj][m][1];
                    u32x4 w; w.x = cvt_pk_bf16(v0[0], v0[1]); w.y = cvt_pk_bf16(v0[2], v0[3]); w.z = cvt_pk_bf16(v1[0], v1[1]); w.w = cvt_pk_bf16(v1[2], v1[3]);
                    *(u32x4*)(rowp + bj * HALF) = w; } }
    }
};

struct EpiSwiglu {
    static constexpr bool PERM = true, AFTER_DRAIN = false, HAS_INIT = true, HAS_ACC_INIT = false, HAS_XT = false;
    bf16_t* H; int ldh; const float* ssq;
    template <class Sched> __device__ __forceinline__ void phase_init(const Sched& S, PG8_LAS float* tab, int tid) const {
        Unit u;
        for (int i = 0; S.next(i, u); ++i)
            if (tid < 256) tab[i * 256 + tid] = __builtin_amdgcn_rsqf(part8(ssq + (size_t)(u.pm * BM + tid) * 8) * (1.0f / 2048.0f) + EPS);
    }
    __device__ __forceinline__ void operator()(const f32x4 (&acc)[2][2][4][2], const Unit& u, int wr, int wc, int fr, int fq, const PG8_LAS float* tab) const {
        const int row0 = u.pm * BM + wr * 64 + fr, col0 = u.pn * HALF + wc * 32 + 8 * fq;
#pragma unroll
        for (int ai = 0; ai < 2; ++ai)
#pragma unroll
            for (int m = 0; m < 4; ++m) { const int row = row0 + ai * HALF + m * 16;
                const float rs = tab[ai * HALF + wr * 64 + m * 16 + fr];
                float hv[8];
#pragma unroll
                for (int n = 0; n < 2; ++n)
#pragma unroll
                    for (int j = 0; j < 4; ++j) { const float g = acc[ai][0][m][n][j] * rs, up = acc[ai][1][m][n][j] * rs;
                        const float e = __builtin_amdgcn_exp2f(g * -1.4426950408889634f);
                        hv[4 * n + j] = g * up * __builtin_amdgcn_rcpf(1.0f + e); }
                u32x4 w; w.x = cvt_pk_bf16(hv[0], hv[1]); w.y = cvt_pk_bf16(hv[2], hv[3]); w.z = cvt_pk_bf16(hv[4], hv[5]); w.w = cvt_pk_bf16(hv[6], hv[7]);
                *(u32x4*)(H + (size_t)row * ldh + col0) = w; }
    }
};

struct EpiResid {
    static constexpr bool PERM = true, AFTER_DRAIN = false, HAS_INIT = false, HAS_ACC_INIT = true, HAS_XT = true;
    const float* xin; float* xout; bf16_t* xb; float* ssq_next; float f; int in_f32, out_f32;
    __device__ __forceinline__ void init_acc(f32x4 (&acc)[2][2][4][2], const Unit& u, int wr, int wc, int fr, int fq) const {
        const int row0 = u.pm * BM + wr * 64 + fr, col0 = u.pn * BM + wc * 32 + 8 * fq; const float rf = 1.0f / f;
#pragma unroll
        for (int ai = 0; ai < 2; ++ai)
#pragma unroll
            for (int m = 0; m < 4; ++m)
#pragma unroll
                for (int bj = 0; bj < 2; ++bj) { const size_t o2 = (size_t)(row0 + ai * HALF + m * 16) * 2048 + col0 + bj * HALF;
                    if (in_f32) { acc[ai][bj][m][0] = *(const f32x4*)(xin + o2) * rf; acc[ai][bj][m][1] = *(const f32x4*)(xin + o2 + 4) * rf; }
                    else { const u32x4 w = *(const u32x4*)(xb + o2);
                        acc[ai][bj][m][0] = (f32x4){__uint_as_float(w.x << 16), __uint_as_float(w.x & 0xffff0000u), __uint_as_float(w.y << 16), __uint_as_float(w.y & 0xffff0000u)} * rf;
                        acc[ai][bj][m][1] = (f32x4){__uint_as_float(w.z << 16), __uint_as_float(w.z & 0xffff0000u), __uint_as_float(w.w << 16), __uint_as_float(w.w & 0xffff0000u)} * rf; } }
    }
    __device__ __forceinline__ void operator()(const f32x4 (&acc)[2][2][4][2], const Unit& u, int wr, int wc, int fr, int fq, PG8_LAS float* xt) const {
        const int row0 = u.pm * BM + wr * 64 + fr, col0 = u.pn * BM + wc * 32 + 8 * fq;
#pragma unroll
        for (int ai = 0; ai < 2; ++ai)
#pragma unroll
            for (int m = 0; m < 4; ++m) { const int row = row0 + ai * HALF + m * 16; const size_t off = (size_t)row * 2048 + col0; float s = 0.f;
#pragma unroll
                for (int bj = 0; bj < 2; ++bj) { const size_t o2 = off + bj * HALF;
                    f32x4 x0 = acc[ai][bj][m][0] * f, x1 = acc[ai][bj][m][1] * f;
                    if (out_f32) { *(f32x4*)(xout + o2) = x0; *(f32x4*)(xout + o2 + 4) = x1; }
                    else { u32x4 w; w.x = cvt_pk_bf16(x0[0], x0[1]); w.y = cvt_pk_bf16(x0[2], x0[3]); w.z = cvt_pk_bf16(x1[0], x1[1]); w.w = cvt_pk_bf16(x1[2], x1[3]);
                        asm volatile("global_store_dwordx4 %0, %1, off sc1\n\ts_nop 1" :: "v"(xb + o2), "v"(w) : "memory");
                        x0 = (f32x4){__uint_as_float(w.x << 16), __uint_as_float(w.x & 0xffff0000u), __uint_as_float(w.y << 16), __uint_as_float(w.y & 0xffff0000u)};
                        x1 = (f32x4){__uint_as_float(w.z << 16), __uint_as_float(w.z & 0xffff0000u), __uint_as_float(w.w << 16), __uint_as_float(w.w & 0xffff0000u)}; }
                    s += (x0[0] * x0[0] + x0[1] * x0[1]) + (x0[2] * x0[2] + x0[3] * x0[3]) + (x1[0] * x1[0] + x1[1] * x1[1]) + (x1[2] * x1[2] + x1[3] * x1[3]); }
                s += __shfl_xor(s, 16); s += __shfl_xor(s, 32);
                if (fq == 0) xt[(ai * HALF + wr * 64 + m * 16 + fr) * 4 + wc] = s; }
        asm volatile("s_waitcnt lgkmcnt(0)" ::: "memory"); __builtin_amdgcn_s_barrier(); asm volatile("" ::: "memory");
        const int tid = (wr * 4 + wc) * 64 + fq * 16 + fr;
        if (tid < 256) { const f32x4 p = *(const PG8_LAS f32x4*)(xt + tid * 4); ssq_next[(size_t)(u.pm * BM + tid) * 8 + u.pn] = (p[0] + p[1]) + (p[2] + p[3]); }
    }
};

struct EpiWin {
    static constexpr bool PERM = false, AFTER_DRAIN = false, HAS_INIT = false, HAS_ACC_INIT = false, HAS_XT = true;
    bf16_t *U, *Q, *Kb, *V; const float* ssq; float* ssq_qk; const float *qg, *kg; const float *cosT, *sinT;
    __device__ __forceinline__ void operator()(const f32x4 (&acc)[2][2][4][2], const Unit& u, int wr, int wc, int fr, int fq, PG8_LAS float* xt) const {
        const int row0 = u.pm * BM + wr * 64 + fr; const int pn = u.pn;
        if (pn < 4 || pn >= 12) {
            bf16_t* O = (pn < 4) ? U : V; const int col0 = (pn & 3) * BM + wc * 32 + 8 * fq;
#pragma unroll
            for (int ai = 0; ai < 2; ++ai)
#pragma unroll
                for (int m = 0; m < 4; ++m) { const int row = row0 + ai * HALF + m * 16;
                    const float rs = __builtin_amdgcn_rsqf(part8(ssq + (size_t)row * 8) * (1.0f / 2048.0f) + EPS);
                    bf16_t* rowp = O + (size_t)row * 1024 + col0;
#pragma unroll
                    for (int bj = 0; bj < 2; ++bj) { const f32x4 v0 = acc[ai][bj][m][0] * rs, v1 = acc[ai][bj][m][1] * rs;
                        u32x4 w; w.x = cvt_pk_bf16(v0[0], v0[1]); w.y = cvt_pk_bf16(v0[2], v0[3]); w.z = cvt_pk_bf16(v1[0], v1[1]); w.w = cvt_pk_bf16(v1[2], v1[3]);
                        *(u32x4*)(rowp + bj * HALF) = w; } }
        } else {
            const bool isq = pn < 8; bf16_t* O = isq ? Q : Kb; const float* gain = isq ? qg : kg;
            const int d1 = 16 * wc + 4 * fq;
            const f32x4 g1 = *(const f32x4*)(gain + d1), g2 = *(const f32x4*)(gain + d1 + 64);
#pragma unroll
            for (int ai = 0; ai < 2; ++ai)
#pragma unroll
                for (int m = 0; m < 4; ++m) { const int row = row0 + ai * HALF + m * 16;
                    const f32x4 cs = *(const f32x4*)(cosT + (size_t)row * 64 + d1), sn = *(const f32x4*)(sinT + (size_t)row * 64 + d1);
#pragma unroll
                    for (int bj = 0; bj < 2; ++bj) { const f32x4 x1 = acc[ai][bj][m][0], x2 = acc[ai][bj][m][1];
                        float s = (x1[0] * x1[0] + x1[1] * x1[1]) + (x1[2] * x1[2] + x1[3] * x1[3]) + (x2[0] * x2[0] + x2[1] * x2[1]) + (x2[2] * x2[2] + x2[3] * x2[3]);
                        s += __shfl_xor(s, 16); s += __shfl_xor(s, 32);
                        const int hidx = (pn - 4) * 2 + bj;
                        if (fq == 0) xt[((ai * HALF + wr * 64 + m * 16 + fr) * 2 + bj) * 4 + wc] = s;
                        const f32x4 a1 = x1 * g1, a2 = x2 * g2;
                        const f32x4 y1 = a1 * cs - a2 * sn, y2 = a2 * cs + a1 * sn;
                        u32x2 w1; w1.x = cvt_pk_bf16(y1[0], y1[1]); w1.y = cvt_pk_bf16(y1[2], y1[3]);
                        u32x2 w2; w2.x = cvt_pk_bf16(y2[0], y2[1]); w2.y = cvt_pk_bf16(y2[2], y2[3]);
                        const bool odd = (fq & 1) != 0;
                        const unsigned sx = odd ? w1.x : w2.x, sy = odd ? w1.y : w2.y;
                        const unsigned rx = (unsigned)__shfl_xor((int)sx, 16), ry = (unsigned)__shfl_xor((int)sy, 16);
                        u32x4 wv; if (odd) { wv.x = rx; wv.y = ry; wv.z = w2.x; wv.w = w2.y; } else { wv.x = w1.x; wv.y = w1.y; wv.z = rx; wv.w = ry; }
                        bf16_t* p = O + (size_t)row * 1024 + (hidx & 7) * 128 + (odd ? (64 + d1 - 4) : d1);
                        *(u32x4*)p = wv; } }
            asm volatile("s_waitcnt lgkmcnt(0)" ::: "memory"); __builtin_amdgcn_s_barrier(); asm volatile("" ::: "memory");
            const int tid = (wr * 4 + wc) * 64 + fq * 16 + fr;
            { const f32x4 pq = *(const PG8_LAS f32x4*)(xt + tid * 4); ssq_qk[(size_t)(u.pm * BM + (tid >> 1)) * 16 + (pn - 4) * 2 + (tid & 1)] = (pq[0] + pq[1]) + (pq[2] + pq[3]); }
        }
    }
};

template <class Epi, class Sched, bool ALIGN_EPI, bool SP2, int KK, int LDA, int APN>
__device__ __forceinline__ void gemm_phase(PG8_LAS unsigned char* lds, const Gemm g, const Sched& S, const Epi& E, const int wid) {
    int lane_ = (int)__builtin_amdgcn_mbcnt_hi(~0u, __builtin_amdgcn_mbcnt_lo(~0u, 0u)); asm volatile("" : "+v"(lane_));
    const int lane = lane_, tid = wid * 64 + lane, wr = wid >> 2, wc = wid & 3, fr = lane & 15, fq = lane >> 4;
    constexpr int K = KK, nt = K / BK;
    unsigned voffA[2], voffB[2];
#pragma unroll
    for (int i = 0; i < 2; ++i) { int R, C; stage_rc(tid * 16 + i * 8192, R, C); const int Rb = Epi::PERM ? ((R & ~31) + perm32(R & 31)) : R;
        voffA[i] = (unsigned)(R * LDA + C) * 2u; voffB[i] = (unsigned)(Rb * K + C) * 2u; }
    const size_t kstep = (size_t)(BK * 2);
    const size_t hstep = (size_t)HALF * K * 2;
    const size_t tstep = 2 * hstep;
    const size_t hstepA = (size_t)HALF * LDA * 2, tstepA = 2 * hstepA;
    const unsigned ldsw = (unsigned)wid * 1024u;
    const int aoff = lds_byte(wr * 64 + fr, fq * 8), boff = lds_byte(wc * 32 + fr, fq * 8);
#define PG8_SA(b, h) (((b) * 2 + (h)) * HTB)
#define PG8_SB(b, h) ((4 + (b) * 2 + (h)) * HTB)
#define PG8_STAGE(bufoff, gbase, voff) do { _Pragma("unroll") for (int _i = 0; _i < 2; ++_i) \
        __builtin_amdgcn_global_load_lds((const unsigned*)((const char*)(gbase) + (voff)[_i]), (PG8_LAS unsigned*)(lds + (bufoff) + ldsw + _i * 8192), 16, 0, 0); } while (0)
#define PG8_LDA(dst, b, h) do { _Pragma("unroll") for (int m = 0; m < 4; ++m) _Pragma("unroll") for (int k = 0; k < 2; ++k) dst[m][k] = *(const PG8_LAS bf16x8*)(lds + PG8_SA(b, h) + aoff + m * 2048 + k * 1024); } while (0)
#define PG8_LDB(dst, b, h) do { _Pragma("unroll") for (int n = 0; n < 2; ++n) _Pragma("unroll") for (int k = 0; k < 2; ++k) dst[n][k] = *(const PG8_LAS bf16x8*)(lds + PG8_SB(b, h) + boff + n * 2048 + k * 1024); } while (0)
#define PG8_MMA(ai, bj, At, Bt) do { __builtin_amdgcn_s_setprio(1); _Pragma("unroll") for (int m = 0; m < 4; ++m) _Pragma("unroll") for (int n = 0; n < 2; ++n) _Pragma("unroll") for (int k = 0; k < 2; ++k) \
        acc[ai][bj][m][n] = __builtin_amdgcn_mfma_f32_16x16x32_bf16(Bt[n][k], At[m][k], acc[ai][bj][m][n], 0, 0, 0); __builtin_amdgcn_s_setprio(0); } while (0)
#define PG8_WAIT_V(n) asm volatile("s_waitcnt vmcnt(" #n ")" ::: "memory")
#define PG8_WAIT_L(n) asm volatile("s_waitcnt lgkmcnt(" #n ")" ::: "memory")
#define PG8_BAR __builtin_amdgcn_s_barrier()
#define PG8_SCHED __builtin_amdgcn_sched_barrier(0)
    Unit cur, nxt; int ui = 0;
    if (!S.next(0, cur)) return;
    PG8_LAS float* etab = (PG8_LAS float*)(lds + STAGE_BYTES);
    if constexpr (Epi::HAS_INIT) { E.phase_init(S, etab, tid); asm volatile("s_waitcnt vmcnt(0) lgkmcnt(0)" ::: "memory"); __builtin_amdgcn_s_barrier(); asm volatile("" ::: "memory"); }
    f32x4 acc[2][2][4][2];
#pragma unroll
    for (int a = 0; a < 2; ++a)
#pragma unroll
        for (int b = 0; b < 2; ++b)
#pragma unroll
            for (int m = 0; m < 4; ++m)
#pragma unroll
                for (int n = 0; n < 2; ++n) acc[a][b][m][n] = (f32x4){0.f, 0.f, 0.f, 0.f};
    if constexpr (Epi::HAS_ACC_INIT) E.init_acc(acc, cur, wr, wc, fr, fq);
    bf16x8 At[4][2], B0[2][2], B1[2][2];
    const char* cA = (const char*)g.A + (size_t)cur.pm * tstepA + (size_t)cur.pn * APN; const char* cB = (const char*)g.Bt + (size_t)cur.pn * tstep;
    S.a_ready(cur);
    if constexpr (SP2) {
        PG8_STAGE(PG8_SB(0, 0), cB, voffB); PG8_STAGE(PG8_SB(0, 1), cB + hstep, voffB); PG8_STAGE(PG8_SA(0, 0), cA, voffA); PG8_STAGE(PG8_SA(0, 1), cA + hstepA, voffA);
        if (wr == 1) PG8_BAR;
        PG8_WAIT_V(2); PG8_BAR;
        PG8_STAGE(PG8_SB(1, 0), cB + kstep, voffB); PG8_STAGE(PG8_SA(1, 0), cA + kstep, voffA); PG8_STAGE(PG8_SB(1, 1), cB + hstep + kstep, voffB);
        PG8_WAIT_V(6); PG8_BAR;
    } else {
        PG8_STAGE(PG8_SB(0, 0), cB, voffB); PG8_STAGE(PG8_SA(0, 0), cA, voffA); PG8_STAGE(PG8_SB(0, 1), cB + hstep, voffB); PG8_STAGE(PG8_SA(0, 1), cA + hstepA, voffA);
        if (wr == 1) PG8_BAR;
        PG8_WAIT_V(4); PG8_BAR;
        PG8_STAGE(PG8_SB(1, 0), cB + kstep, voffB); PG8_STAGE(PG8_SA(1, 0), cA + kstep, voffA); PG8_STAGE(PG8_SB(1, 1), cB + hstep + kstep, voffB);
        PG8_WAIT_V(6); PG8_BAR;
    }
    for (;;) {
        const bool has_next = S.next(ui + 1, nxt);
        const char* nA = has_next ? (const char*)g.A + (size_t)nxt.pm * tstepA + (size_t)nxt.pn * APN : cA; const char* nB = has_next ? (const char*)g.Bt + (size_t)nxt.pn * tstep : cB;
#pragma unroll 1
        for (int t = 0; t < nt; t += 2) {
            const bool last = (t == nt - 2);
            const char* a1 = cA + (size_t)(t + 1) * kstep;
            const char* a2 = last ? nA : cA + (size_t)(t + 2) * kstep; const char* b2 = last ? nB : cB + (size_t)(t + 2) * kstep;
            const char* a3 = a2 + kstep; const char* b3 = b2 + kstep;
            if (last && has_next) S.a_ready(nxt);
            if constexpr (SP2) {
            PG8_LDB(B0, 0, 0); PG8_LDB(B1, 0, 1); PG8_SCHED; PG8_LDA(At, 0, 0); PG8_STAGE(PG8_SA(1, 1), a1 + hstepA, voffA);
            PG8_WAIT_V(8); PG8_WAIT_L(0); PG8_BAR; PG8_MMA(0, 0, At, B0); PG8_MMA(0, 1, At, B1); PG8_BAR; PG8_SCHED;
            PG8_LDA(At, 0, 1); PG8_STAGE(PG8_SB(0, 0), b2, voffB); PG8_STAGE(PG8_SB(0, 1), b2 + hstep, voffB); PG8_STAGE(PG8_SA(0, 0), a2, voffA);
            PG8_WAIT_V(8); PG8_WAIT_L(0); PG8_BAR; PG8_MMA(1, 0, At, B0); PG8_MMA(1, 1, At, B1); PG8_BAR; PG8_SCHED;
            PG8_LDB(B0, 1, 0); PG8_LDB(B1, 1, 1); PG8_SCHED; PG8_LDA(At, 1, 0); PG8_STAGE(PG8_SA(0, 1), a2 + hstepA, voffA);
            PG8_WAIT_V(8); PG8_WAIT_L(0); PG8_BAR; PG8_MMA(0, 0, At, B0); PG8_MMA(0, 1, At, B1); PG8_BAR; PG8_SCHED;
            PG8_LDA(At, 1, 1); PG8_STAGE(PG8_SB(1, 0), b3, voffB); PG8_STAGE(PG8_SB(1, 1), b3 + hstep, voffB); PG8_STAGE(PG8_SA(1, 0), a3, voffA);
            PG8_WAIT_V(8); PG8_WAIT_L(0); PG8_BAR; PG8_MMA(1, 0, At, B0); PG8_MMA(1, 1, At, B1); PG8_BAR; PG8_SCHED;
            } else {
            PG8_LDB(B0, 0, 0); PG8_SCHED; PG8_LDA(At, 0, 0); PG8_STAGE(PG8_SA(1, 1), a1 + hstepA, voffA);
            PG8_WAIT_L(8); PG8_BAR; PG8_WAIT_L(0); PG8_MMA(0, 0, At, B0); PG8_BAR; PG8_SCHED;
            PG8_LDB(B1, 0, 1); PG8_STAGE(PG8_SB(0, 0), b2, voffB);
            PG8_BAR; PG8_WAIT_L(0); PG8_MMA(0, 1, At, B1); PG8_BAR;
            PG8_LDA(At, 0, 1); PG8_STAGE(PG8_SA(0, 0), a2, voffA);
            PG8_BAR; PG8_WAIT_L(0); PG8_MMA(1, 0, At, B0); PG8_BAR; PG8_SCHED;
            PG8_STAGE(PG8_SB(0, 1), b2 + hstep, voffB);
            PG8_WAIT_V(6); PG8_BAR; PG8_MMA(1, 1, At, B1); PG8_BAR;
            PG8_LDB(B0, 1, 0); PG8_SCHED; PG8_LDA(At, 1, 0); PG8_STAGE(PG8_SA(0, 1), a2 + hstepA, voffA);
            PG8_WAIT_L(8); PG8_BAR; PG8_WAIT_L(0); PG8_MMA(0, 0, At, B0); PG8_BAR; PG8_SCHED;
            PG8_LDB(B1, 1, 1); PG8_STAGE(PG8_SB(1, 0), b3, voffB);
            PG8_BAR; PG8_WAIT_L(0); PG8_MMA(0, 1, At, B1); PG8_BAR;
            PG8_LDA(At, 1, 1); PG8_STAGE(PG8_SA(1, 0), a3, voffA);
            PG8_BAR; PG8_WAIT_L(0); PG8_MMA(1, 0, At, B0); PG8_BAR; PG8_SCHED;
            PG8_STAGE(PG8_SB(1, 1), b3 + hstep, voffB);
            PG8_WAIT_V(6); PG8_BAR; PG8_MMA(1, 1, At, B1); PG8_BAR;
            }
        }
        if constexpr (ALIGN_EPI) { if (wr == 0) PG8_BAR; }
        if constexpr (!Epi::AFTER_DRAIN) { if constexpr (Epi::HAS_INIT) E(acc, cur, wr, wc, fr, fq, etab + ui * 256); else if constexpr (Epi::HAS_XT) E(acc, cur, wr, wc, fr, fq, etab); else E(acc, cur, wr, wc, fr, fq); S.done(cur); }
        if (!has_next) break;
#pragma unroll
        for (int a = 0; a < 2; ++a)
#pragma unroll
            for (int b = 0; b < 2; ++b)
#pragma unroll
                for (int m = 0; m < 4; ++m)
#pragma unroll
                    for (int n = 0; n < 2; ++n) acc[a][b][m][n] = (f32x4){0.f, 0.f, 0.f, 0.f};
        if constexpr (Epi::HAS_ACC_INIT) E.init_acc(acc, nxt, wr, wc, fr, fq);
        cur = nxt; cA = nA; cB = nB; ++ui;
        if constexpr (ALIGN_EPI) { if (wr == 1) PG8_BAR; }
    }
    PG8_WAIT_V(0);
    if constexpr (!ALIGN_EPI) { if (wr == 0) PG8_BAR; }
    PG8_BAR;
    if constexpr (Epi::AFTER_DRAIN) { E.fused(acc, cur, wr, wc, fr, fq, lds, wid, lane); S.done(cur); }
#undef PG8_SA
#undef PG8_SB
#undef PG8_STAGE
#undef PG8_LDA
#undef PG8_LDB
#undef PG8_MMA
#undef PG8_WAIT_V
#undef PG8_WAIT_L
#undef PG8_BAR
#undef PG8_SCHED
}
}

#define LAS __attribute__((address_space(3)))
typedef unsigned short bf16;
typedef float f32x4 __attribute__((ext_vector_type(4)));
typedef float f32x16 __attribute__((ext_vector_type(16)));
typedef short bf16x8 __attribute__((ext_vector_type(8)));
typedef short s16x4 __attribute__((ext_vector_type(4)));
typedef unsigned u32x4 __attribute__((ext_vector_type(4)));
typedef unsigned u32x2 __attribute__((ext_vector_type(2)));

constexpr int S = 8192, D = 2048, FF = 5632, NGU = 2 * FF, INW = 4096, PW = 1024, NH = 8, HD = 128, DEPTH = 2;
constexpr int NWAVES = 8, NTHREADS = 512;
constexpr int LDS_BYTES = 163840;
constexpr float EPSF = 1e-6f;

constexpr size_t MiB = 1u << 20;
constexpr size_t WS_SSQX = 0;
constexpr size_t WS_BAR = 512 * 1024;
constexpr size_t WS_SSQQK = 1 * MiB;
constexpr size_t WS_ML = 3 * MiB;
constexpr size_t WS_COS = 5 * MiB, WS_SIN = 7 * MiB;
constexpr size_t WS_W = 9 * MiB;
constexpr size_t SZ_WGU = (size_t)NGU * D * 2, SZ_WD = (size_t)D * FF * 2, SZ_WIN = (size_t)INW * D * 2, SZ_WOUT = (size_t)D * D * 2, SZ_PW = (size_t)PW * 256 * 2;
constexpr size_t OFF_WGU1 = 0, OFF_WD1 = OFF_WGU1 + SZ_WGU, OFF_WIN = OFF_WD1 + SZ_WD, OFF_PW = OFF_WIN + SZ_WIN, OFF_WOUT = OFF_PW + SZ_PW, OFF_WGU2 = OFF_WOUT + SZ_WOUT, OFF_WD2 = OFF_WGU2 + SZ_WGU, SZ_LAYER = OFF_WD2 + SZ_WD;
constexpr size_t WS_XB = WS_W + DEPTH * SZ_LAYER;
constexpr size_t WS_A2 = WS_XB + (size_t)S * D * 2;
constexpr size_t WS_H = WS_A2 + (size_t)S * D * 2;
constexpr size_t WS_OPART = WS_H + (size_t)S * FF * 2;
constexpr size_t WS_PART = WS_OPART + (size_t)3 * S * 1024 * 4;
constexpr size_t WS_END = WS_PART + 2 * MiB;

__device__ __forceinline__ float bf2f(unsigned short b) { return __uint_as_float((unsigned)b << 16); }
__device__ __forceinline__ unsigned f2bf(float f) { unsigned u = __float_as_uint(f); return (u + 0x7fffu + ((u >> 16) & 1u)) >> 16; }
__device__ __forceinline__ unsigned pk2(float lo, float hi) { return f2bf(lo) | (f2bf(hi) << 16); }
__device__ __forceinline__ float wave_sum(float v) {
#pragma unroll
    for (int o = 1; o < 64; o <<= 1) v += __shfl_xor(v, o);
    return v;
}

__device__ __forceinline__ int row_map(int mode, int n) {
    if (mode == 0) return n;
    if (mode == 1) return (n >> 7) * 256 + (n & 127);
    if (mode == 2) return (n >> 7) * 256 + 128 + (n & 127);
    if (n < 1024 || n >= 3072) { const int c = n & 31; return (n & ~31) + 16 * ((c >> 2) & 1) + 4 * (c >> 3) + (c & 3); }
    const int dd = (n - 1024) & 127; return (n - dd) + ((((dd >> 4) & 3) << 5) | ((dd >> 6) << 4) | (dd & 15));
}
constexpr int TRP = 144;
__device__ __forceinline__ void tr_item64(const float* __restrict__ W, int K, int N, bf16* __restrict__ WT, const float* rowgain, const float* colgain, int mode, LAS unsigned char* scr, int item, int lane) {
    const int nblk = N >> 6, kb = item / nblk, nb = item - kb * nblk, k0 = 64 * kb, n0 = 64 * nb;
    const int g = lane >> 4, c = lane & 15;
    f32x4 v[16];
    const float* src = W + (size_t)(k0 + 16 * g) * N + n0 + 4 * c;
#pragma unroll
    for (int j = 0; j < 16; ++j) v[j] = __builtin_nontemporal_load((const f32x4*)(src + (size_t)j * N));
    f32x4 cg4 = (f32x4){1.f, 1.f, 1.f, 1.f};
    if (colgain) cg4 = *(const f32x4*)(colgain + n0 + 4 * c);
    if (rowgain) {
#pragma unroll
        for (int q = 0; q < 4; ++q) { const f32x4 r4 = *(const f32x4*)(rowgain + k0 + 16 * g + 4 * q);
#pragma unroll
            for (int e = 0; e < 4; ++e) v[4 * q + e] = v[4 * q + e] * r4[e]; }
    }
#pragma unroll
    for (int i = 0; i < 4; ++i) {
        u32x4 lo, hi;
        lo.x = pg8::cvt_pk_bf16(v[0][i] * cg4[i], v[1][i] * cg4[i]);   lo.y = pg8::cvt_pk_bf16(v[2][i] * cg4[i], v[3][i] * cg4[i]);
        lo.z = pg8::cvt_pk_bf16(v[4][i] * cg4[i], v[5][i] * cg4[i]);   lo.w = pg8::cvt_pk_bf16(v[6][i] * cg4[i], v[7][i] * cg4[i]);
        hi.x = pg8::cvt_pk_bf16(v[8][i] * cg4[i], v[9][i] * cg4[i]);   hi.y = pg8::cvt_pk_bf16(v[10][i] * cg4[i], v[11][i] * cg4[i]);
        hi.z = pg8::cvt_pk_bf16(v[12][i] * cg4[i], v[13][i] * cg4[i]); hi.w = pg8::cvt_pk_bf16(v[14][i] * cg4[i], v[15][i] * cg4[i]);
        LAS unsigned char* p = scr + (4 * c + i) * TRP + 32 * g;
        *(LAS u32x4*)p = lo; *(LAS u32x4*)(p + 16) = hi;
    }
    asm volatile("s_waitcnt lgkmcnt(0)" ::: "memory");
#pragma unroll
    for (int m = 0; m < 8; ++m) { const int row = 8 * m + (lane >> 3), ch = lane & 7;
        const u32x4 o = *(const LAS u32x4*)(scr + row * TRP + ch * 16);
        *(u32x4*)(WT + (size_t)row_map(mode, n0 + row) * K + k0 + 8 * ch) = o; }
    asm volatile("s_waitcnt lgkmcnt(0)" ::: "memory");
}

constexpr int TCP = 528, TC_BUF = 128 * TCP;
__device__ __forceinline__ void tr_item_cu(const float* __restrict__ W, int K, int N, bf16* __restrict__ WT, const float* rowgain, int mode, LAS unsigned char* buf, int item, int wave, int lane) {
    const int nblk = N >> 7, kb = item / nblk, nb = item - kb * nblk, k0 = 256 * kb, n0 = 128 * nb;
    const int hr = lane >> 5, c = lane & 31, kw = 32 * wave + 16 * hr;
    f32x4 v[16];
    const float* src = W + (size_t)(k0 + kw) * N + n0 + 4 * c;
#pragma unroll
    for (int j = 0; j < 16; ++j) v[j] = __builtin_nontemporal_load((const f32x4*)(src + (size_t)j * N));
    if (rowgain) {
#pragma unroll
        for (int q = 0; q < 4; ++q) { const f32x4 r4 = *(const f32x4*)(rowgain + k0 + kw + 4 * q);
#pragma unroll
            for (int e = 0; e < 4; ++e) v[4 * q + e] = v[4 * q + e] * r4[e]; }
    }
#pragma unroll
    for (int i = 0; i < 4; ++i) {
        u32x4 lo, hi;
        lo.x = pg8::cvt_pk_bf16(v[0][i], v[1][i]);   lo.y = pg8::cvt_pk_bf16(v[2][i], v[3][i]);   lo.z = pg8::cvt_pk_bf16(v[4][i], v[5][i]);   lo.w = pg8::cvt_pk_bf16(v[6][i], v[7][i]);
        hi.x = pg8::cvt_pk_bf16(v[8][i], v[9][i]);   hi.y = pg8::cvt_pk_bf16(v[10][i], v[11][i]); hi.z = pg8::cvt_pk_bf16(v[12][i], v[13][i]); hi.w = pg8::cvt_pk_bf16(v[14][i], v[15][i]);
        LAS unsigned char* p = buf + (4 * c + i) * TCP + kw * 2;
        *(LAS u32x4*)p = lo; *(LAS u32x4*)(p + 16) = hi;
    }
    __syncthreads();
#pragma unroll
    for (int m = 0; m < 8; ++m) { const int row = 16 * wave + 2 * m + hr;
        const u32x4 o = *(const LAS u32x4*)(buf + row * TCP + c * 16);
        asm volatile("global_store_dwordx4 %0, %1, off sc1\n\ts_nop 1" :: "v"(WT + (size_t)row_map(mode, n0 + row) * K + k0 + 8 * c), "v"(o) : "memory"); }
}

__device__ __forceinline__ int crow(int r, int hi) { return (r & 3) + 8 * (r >> 2) + 4 * hi; }
constexpr int VPITCH = 320, KPITCH = 272, K_OFF = 10240, CK_OFF = 18944, WLDS = 19584;
constexpr int XB_ST_OFF = 8 * WLDS + 64;
__device__ __forceinline__ void attn_wave_unit(LAS unsigned char* wl, const bf16* __restrict__ Q, const bf16* __restrict__ Kb, const bf16* __restrict__ V, const float* ssq_x, const float* ssq_qk,
                                               bf16* Opart, float* Mpart, float* Lpart, int h, int p, int d, int r, int a0, int nvalid, int lane) {
    const int L = S / d; const int qi = lane & 31, hh = lane >> 5;
    LAS float* ckl = (LAS float*)(wl + CK_OFF);
    for (int i = lane; i < 160; i += 64) {
        int ka = a0 - 64 + i; ka = ka < 0 ? 0 : (ka > L - 1 ? L - 1 : ka); const int pos = r + d * ka;
        const float rs = __builtin_amdgcn_rsqf(pg8::part8(ssq_x + (size_t)pos * 8) * (1.0f / 2048.0f) + EPSF);
        const float sk = ssq_qk[(size_t)pos * 16 + 8 + h];
        ckl[i] = rs * __builtin_amdgcn_rsqf(rs * rs * sk * (1.0f / 128.0f) + EPSF);
    }
    const int aq = (a0 + qi) > L - 1 ? L - 1 : (a0 + qi); const int qpos = r + d * aq;
    float cq;
    { const float rs = __builtin_amdgcn_rsqf(pg8::part8(ssq_x + (size_t)qpos * 8) * (1.0f / 2048.0f) + EPSF); const float sq = ssq_qk[(size_t)qpos * 16 + h];
      cq = rs * __builtin_amdgcn_rsqf(rs * rs * sq * (1.0f / 128.0f) + EPSF) * (0.08838834764831845f * 1.4426950408889634f); }
    bf16x8 qf[8];
    { const bf16* qrow = Q + (size_t)qpos * 1024 + h * 128 + 8 * hh;
#pragma unroll
      for (int ks = 0; ks < 8; ++ks) qf[ks] = *(const bf16x8*)(qrow + 16 * ks); }
    f32x16 o[4];
#pragma unroll
    for (int db = 0; db < 4; ++db)
#pragma unroll
        for (int e = 0; e < 16; ++e) o[db][e] = 0.f;
    float m_run = -1e30f, l_run = 0.f;
    asm volatile("s_waitcnt lgkmcnt(0)" ::: "memory");
    const int qa = a0 + qi;
    const int trbase = (4 * hh + ((lane & 15) >> 2)) * VPITCH + (16 * ((lane >> 4) & 1) + 4 * (lane & 3)) * 2;
    u32x4 kr[8], vr[8];
#define ATT_LOAD_KV(t_) do { _Pragma("unroll") for (int i = 0; i < 8; ++i) { int vi = a0 - 64 + 32 * (t_) + 4 * i + (lane >> 4); vi = vi < 0 ? 0 : (vi > L - 1 ? L - 1 : vi); \
        const size_t go = (size_t)(r + d * vi) * 1024 + h * 128 + (lane & 15) * 8; kr[i] = *(const u32x4*)(Kb + go); vr[i] = *(const u32x4*)(V + go); } } while (0)
    ATT_LOAD_KV(0);
    const int kfbase = K_OFF + qi * KPITCH + 16 * hh;
#pragma unroll 1
    for (int t = 0; t < 5; ++t) {
        const int kb = a0 - 64 + 32 * t;
#pragma unroll
        for (int i = 0; i < 8; ++i) { *(LAS u32x4*)(wl + K_OFF + (4 * i + (lane >> 4)) * KPITCH + (lane & 15) * 16) = kr[i];
                                      *(LAS u32x4*)(wl + (4 * i + (lane >> 4)) * VPITCH + (lane & 15) * 16) = vr[i]; }
        if (t < 4) ATT_LOAD_KV(t + 1);
        asm volatile("s_waitcnt lgkmcnt(0)" ::: "memory");
        f32x16 s, sb;
#pragma unroll
        for (int e = 0; e < 16; ++e) { s[e] = 0.f; sb[e] = 0.f; }
#pragma unroll
        for (int ks = 0; ks < 8; ks += 2) {
            const bf16x8 k0 = *(const LAS bf16x8*)(wl + kfbase + 32 * ks), k1 = *(const LAS bf16x8*)(wl + kfbase + 32 * ks + 32);
            s = __builtin_amdgcn_mfma_f32_32x32x16_bf16(k0, qf[ks], s, 0, 0, 0); sb = __builtin_amdgcn_mfma_f32_32x32x16_bf16(k1, qf[ks + 1], sb, 0, 0, 0); }
        s = s + sb;
        float mt = -INFINITY;
#pragma unroll
        for (int g4 = 0; g4 < 4; ++g4) { const f32x4 ck4 = *(const LAS f32x4*)(ckl + 32 * t + 8 * g4 + 4 * hh);
#pragma unroll
            for (int j = 0; j < 4; ++j) { const int rr = 4 * g4 + j; const int ka = kb + 8 * g4 + 4 * hh + j; const int df = ka - qa;
                const bool ok = ((unsigned)ka < (unsigned)L) & ((unsigned)(df + 64) <= 128u);
                const float v = s[rr] * (cq * ck4[j]); const float sc = ok ? v : -INFINITY; s[rr] = sc; mt = fmaxf(mt, sc); } }
        mt = fmaxf(mt, __shfl_xor(mt, 32));
        const float mn = fmaxf(m_run, mt); const float alpha = __builtin_amdgcn_exp2f(m_run - mn); m_run = mn;
        float ps = 0.f;
#pragma unroll
        for (int e = 0; e < 16; ++e) { const float pe = __builtin_amdgcn_exp2f(s[e] - mn); s[e] = pe; ps += pe; }
        l_run = l_run * alpha + ps;
#pragma unroll
        for (int db = 0; db < 4; ++db)
#pragma unroll
            for (int e = 0; e < 16; ++e) o[db][e] *= alpha;
        bf16x8 pf[2];
#pragma unroll
        for (int s2 = 0; s2 < 2; ++s2) { u32x4 w; w.x = pg8::cvt_pk_bf16(s[8 * s2 + 0], s[8 * s2 + 1]); w.y = pg8::cvt_pk_bf16(s[8 * s2 + 2], s[8 * s2 + 3]);
            w.z = pg8::cvt_pk_bf16(s[8 * s2 + 4], s[8 * s2 + 5]); w.w = pg8::cvt_pk_bf16(s[8 * s2 + 6], s[8 * s2 + 7]); pf[s2] = __builtin_bit_cast(bf16x8, w); }
        bf16x8 vf[2][4];
#pragma unroll
        for (int s2 = 0; s2 < 2; ++s2)
#pragma unroll
            for (int db = 0; db < 4; ++db) {
                const s16x4 lo = __builtin_bit_cast(s16x4, __builtin_amdgcn_ds_read_tr16_b64_v4i16((LAS s16x4*)(wl + trbase + (16 * s2) * VPITCH + db * 64)));
                const s16x4 hi = __builtin_bit_cast(s16x4, __builtin_amdgcn_ds_read_tr16_b64_v4i16((LAS s16x4*)(wl + trbase + (16 * s2 + 8) * VPITCH + db * 64)));
                vf[s2][db] = __builtin_shufflevector(lo, hi, 0, 1, 2, 3, 4, 5, 6, 7); }
#pragma unroll
        for (int s2 = 0; s2 < 2; ++s2)
#pragma unroll
            for (int db = 0; db < 4; ++db) o[db] = __builtin_amdgcn_mfma_f32_32x32x16_bf16(vf[s2][db], pf[s2], o[db], 0, 0, 0);
        asm volatile("s_waitcnt lgkmcnt(0)" ::: "memory");
    }
#undef ATT_LOAD_KV
    const float l_tot = l_run + __shfl_xor(l_run, 32);
#pragma unroll
    for (int db = 0; db < 4; ++db)
#pragma unroll
        for (int g4 = 0; g4 < 4; ++g4) { u32x2 v; v.x = pg8::cvt_pk_bf16(o[db][4 * g4 + 0], o[db][4 * g4 + 1]); v.y = pg8::cvt_pk_bf16(o[db][4 * g4 + 2], o[db][4 * g4 + 3]);
            *(LAS u32x2*)(wl + qi * KPITCH + (32 * db + 8 * g4 + 4 * hh) * 2) = v; }
    asm volatile("s_waitcnt lgkmcnt(0)" ::: "memory");
#pragma unroll
    for (int i = 0; i < 8; ++i) { const int row = 4 * i + (lane >> 4), ar = a0 + row;
        const u32x4 w = *(const LAS u32x4*)(wl + row * KPITCH + (lane & 15) * 16);
        if (row < nvalid && ar < L) { bf16* dst = Opart + ((size_t)p * S + (r + d * ar)) * 1024 + h * 128 + (lane & 15) * 8;
            if (p == 2) asm volatile("global_store_dwordx4 %0, %1, off sc1\n\ts_nop 1" :: "v"(dst), "v"(w) : "memory");
            else *(u32x4*)dst = w; } }
    if (qi < nvalid && (a0 + qi) < L && hh == 0) {
        if (p == 2) { __hip_atomic_store(Mpart + ((size_t)p * S + qpos) * 8 + h, m_run, __ATOMIC_RELAXED, __HIP_MEMORY_SCOPE_AGENT); __hip_atomic_store(Lpart + ((size_t)p * S + qpos) * 8 + h, l_tot, __ATOMIC_RELAXED, __HIP_MEMORY_SCOPE_AGENT); }
        else { Mpart[((size_t)p * S + qpos) * 8 + h] = m_run; Lpart[((size_t)p * S + qpos) * 8 + h] = l_tot; }
    }
    asm volatile("s_waitcnt lgkmcnt(0)" ::: "memory");
}

template <int HW> __device__ __forceinline__ void pooled_item(const bf16* __restrict__ ub, bf16* __restrict__ pb, int s) {
    u32x4 v[2 * HW];
#pragma unroll
    for (int j = 0; j < 2 * HW; ++j) { int t = s - HW + j; t = t < 0 ? 0 : (t > S - 1 ? S - 1 : t); v[j] = *(const u32x4*)(ub + (size_t)t * 1024); }
    float a[8];
#pragma unroll
    for (int e = 0; e < 8; ++e) a[e] = 0.f;
#pragma unroll
    for (int j = 0; j < 2 * HW; ++j) { const int t = s - HW + j; const float mk = (t >= 0 && t < S) ? 1.f : 0.f;
#pragma unroll
        for (int e = 0; e < 4; ++e) { a[2 * e] += mk * __uint_as_float(v[j][e] << 16); a[2 * e + 1] += mk * __uint_as_float(v[j][e] & 0xffff0000u); } }
    const int lo = (s - HW) < 0 ? 0 : (s - HW), hi = (s + HW) > S ? S : (s + HW);
    const float ic = 1.0f / (float)(hi - lo);
    const u32x4 c = v[HW];
    u32x4 ov;
#pragma unroll
    for (int e = 0; e < 4; ++e) ov[e] = pk2(a[2 * e] * ic - __uint_as_float(c[e] << 16), a[2 * e + 1] * ic - __uint_as_float(c[e] & 0xffff0000u));
    asm volatile("global_store_dwordx4 %0, %1, off sc1\n\ts_nop 1" :: "v"(pb + (size_t)s * D), "v"(ov) : "memory");
}

#define XB_TMO      128
#define XB_XCNT(j)  (256  + 64 * (j))
#define XB_XSUB(j)  (1280 + 64 * (j))
#define XB_XGEN(j)  (2304 + 64 * (j))
#define XB_TOP      3328
#define XB_TOPGEN   3392
#define XCD_BAR_WORDS 3456
#define XB_SPIN_CAP (1u << 18)
__device__ __forceinline__ unsigned xb_ld(unsigned* p)              { return __hip_atomic_load(p, __ATOMIC_RELAXED, __HIP_MEMORY_SCOPE_AGENT); }
__device__ __forceinline__ unsigned xb_add(unsigned* p, unsigned v) { return __hip_atomic_fetch_add(p, v, __ATOMIC_RELAXED, __HIP_MEMORY_SCOPE_AGENT); }
__device__ __forceinline__ unsigned xb_xcc_id() { return (unsigned)__builtin_amdgcn_s_getreg((3 << 11) | 20) & 0xFu; }
#define XB_SPIN(cond, bar) do { unsigned _sp = 0; while (cond) { __builtin_amdgcn_s_sleep(1); \
    if ((++_sp & 255u) == 0u) { if (xb_ld(&(bar)[XB_TMO])) break; if (_sp > XB_SPIN_CAP) { atomicAdd(&(bar)[XB_TMO], 1u); break; } } } } while (0)
struct XcdBarrier { unsigned* bar; unsigned x; volatile LAS unsigned* st; };
__device__ __forceinline__ bool xb_leader(int wave) { int l_ = (int)__builtin_amdgcn_mbcnt_hi(~0u, __builtin_amdgcn_mbcnt_lo(~0u, 0u)); asm volatile("" : "+v"(l_)); return wave == 0 && l_ == 0; }
__device__ __forceinline__ XcdBarrier xcd_barrier_post(unsigned* bar, volatile LAS unsigned* st, int wave) {
    XcdBarrier b; b.bar = bar; b.x = xb_xcc_id(); b.st = st;
    if (xb_leader(wave)) (void)xb_add(&bar[XB_XCNT(b.x)], 1u);
    return b;
}
__device__ __forceinline__ void xcd_barrier_complete(unsigned* bar, unsigned x, unsigned& nloc, unsigned& nx) {
    const unsigned G = gridDim.x * gridDim.y * gridDim.z;
    unsigned sum, cnt, mine, sp = 0u;
    for (;;) {
        sum = 0u; cnt = 0u; mine = 0u;
#pragma unroll
        for (unsigned j = 0; j < 16; ++j) { const unsigned c = xb_ld(&bar[XB_XCNT(j)]); sum += c; cnt += (c > 0u) ? 1u : 0u; mine = (j == x) ? c : mine; }
        if (sum == G) break;
        __builtin_amdgcn_s_sleep(1);
        if ((++sp & 255u) == 0u) { if (xb_ld(&bar[XB_TMO])) break; if (sp > XB_SPIN_CAP) { atomicAdd(&bar[XB_TMO], 1u); break; } }
    }
    nloc = mine > 0u ? mine : 1u; nx = cnt > 0u ? cnt : 1u;
}
__device__ __forceinline__ void xcd_barrier(const XcdBarrier& b, int wave) {
    asm volatile("s_waitcnt vmcnt(0)" ::: "memory");
    __syncthreads();
    if (xb_leader(wave)) {
        unsigned* bar = b.bar;
        __builtin_amdgcn_s_waitcnt(0);
        unsigned nloc = b.st[0], nx = b.st[1];
        if (nloc == 0u) { xcd_barrier_complete(bar, b.x, nloc, nx); b.st[0] = nloc; b.st[1] = nx; }
        const unsigned old = xb_add(&bar[XB_XSUB(b.x)], 1u);
        const unsigned gen = old / nloc;
        if (old + 1u == (gen + 1u) * nloc) {
            __builtin_amdgcn_fence(__ATOMIC_RELEASE, "agent");
            asm volatile("s_waitcnt vmcnt(0)" ::: "memory");
            const unsigned og = xb_add(&bar[XB_TOP], 1u);
            const unsigned tg = og / nx;
            if (og + 1u == (tg + 1u) * nx) xb_add(&bar[XB_TOPGEN], 1u);
            else XB_SPIN(xb_ld(&bar[XB_TOPGEN]) == tg, bar);
            __builtin_amdgcn_fence(__ATOMIC_ACQUIRE, "agent");
            xb_add(&bar[XB_XGEN(b.x)], 1u);
            asm volatile("s_waitcnt vmcnt(0)" ::: "memory");
        } else {
            XB_SPIN(xb_ld(&bar[XB_XGEN(b.x)]) == gen, bar);
            __builtin_amdgcn_fence(__ATOMIC_ACQUIRE, "agent");
            asm volatile("s_waitcnt vmcnt(0)" ::: "memory");
        }
    }
    __syncthreads();
}

struct Args { const float* in[16]; float* out; unsigned char* ws; };

#define LANE_ID() ({ int l_ = (int)__builtin_amdgcn_mbcnt_hi(~0u, __builtin_amdgcn_mbcnt_lo(~0u, 0u)); asm volatile("" : "+v"(l_)); l_; })
#define WS_BASE() unsigned char* ws = args.ws; int bidp = bid, Gp = G, wavep = wave; asm volatile("" : "+s"(ws), "+s"(bidp), "+s"(Gp), "+s"(wavep));
#define P_SSQX   ((float*)(ws + WS_PART))
#define P_SSQQK  ((float*)(ws + WS_SSQQK))
#define P_MPART  ((float*)(ws + WS_ML))
#define P_LPART  ((float*)(ws + WS_ML) + 3 * S * 8)
#define P_COS    ((float*)(ws + WS_COS))
#define P_SIN    ((float*)(ws + WS_SIN))
#define P_XB     ((bf16*)(ws + WS_XB))
#define P_A2     ((bf16*)(ws + WS_A2))
#define P_H      ((bf16*)(ws + WS_H))
#define P_U      (P_H)
#define P_Q      (P_H + (size_t)S * 1024)
#define P_K      (P_H + (size_t)2 * S * 1024)
#define P_V      (P_H + (size_t)3 * S * 1024)
#define P_PB     (P_H + (size_t)4 * S * 1024)
#define P_OPART  ((bf16*)(ws + WS_OPART))
#define P_WL(l)  (ws + WS_W + (size_t)(l) * SZ_LAYER)

__global__ void __launch_bounds__(NTHREADS, 2) mega_fwd(Args args) {
    extern __shared__ __attribute__((aligned(16))) unsigned char lds_raw[];
    cg::grid_group grid = cg::this_grid();
    LAS unsigned char* lds = (LAS unsigned char*)lds_raw;
    const int wave = __builtin_amdgcn_readfirstlane(threadIdx.x >> 6);
    const int G = gridDim.x, bid = blockIdx.x;
#define GSYNC(k) xcd_barrier(xbar, wave)

    {
        WS_BASE();
        const int lane = LANE_ID(), tid = wave * 64 + lane, gt = bid * NTHREADS + tid, ngt = G * NTHREADS, gw = bid * NWAVES + wave, ngw = G * NWAVES;
        float* ssq_x = P_SSQX; float* cosT = P_COS; float* sinT = P_SIN; bf16* XB = P_XB; const float* x_in = args.in[0];
        if (bid == 0) for (int i = tid; i < 8192; i += NTHREADS) ((unsigned*)(ws + WS_BAR))[i] = 0u;
        if (tid < 2) ((volatile LAS unsigned*)(lds + XB_ST_OFF))[tid] = 0u;
        for (int i = gt; i < S * 64; i += ngt) { const int s = i >> 6, k = i & 63;
            const float inv = exp2f(-(float)(2 * k) * (1.0f / 128.0f) * 13.287712379549449f);
            const float ang = (float)s * inv; cosT[i] = cosf(ang); sinT[i] = sinf(ang); }
        for (int row = gw; row < S; row += ngw) {
            const f32x4* xr = (const f32x4*)(x_in + (size_t)row * D) + lane; float s = 0.f;
            unsigned long long* o8 = (unsigned long long*)(XB + (size_t)row * D) + lane;
#pragma unroll
            for (int j = 0; j < 8; ++j) { const f32x4 v = xr[64 * j]; s += (v[0] * v[0] + v[1] * v[1]) + (v[2] * v[2] + v[3] * v[3]);
                o8[64 * j] = (unsigned long long)pk2(v[0], v[1]) | ((unsigned long long)pk2(v[2], v[3]) << 32); }
            s = wave_sum(s); if (lane < 8) ssq_x[(size_t)row * 8 + lane] = (lane == 0) ? s : 0.f;
        }
        LAS unsigned char* scr = lds + wave * 16384;
        for (int i = gt; i < DEPTH * 4 * 256 * 64; i += ngt) {
            const int l = i >> 16, rem = i & 65535, g = rem >> 14, c = (rem >> 6) & 255, j4 = (rem & 63) * 4;
            const f32x4 w = *(const f32x4*)(args.in[9] + (((size_t)l * 4 + g) * 256 + c) * 256 + j4); const f32x4 sc = *(const f32x4*)(args.in[10] + (size_t)l * PW + g * 256 + j4);
            u32x2 o; o.x = pk2(w[0] * sc[0], w[1] * sc[1]); o.y = pk2(w[2] * sc[2], w[3] * sc[3]);
            *(u32x2*)((bf16*)(P_WL(l) + OFF_PW) + ((size_t)g * 256 + c) * 256 + j4) = o; }
        constexpr int I_GU = (D / 256) * (FF / 128), I_DN = (FF / 256) * (D / 128), I_IN = (D / 256) * (INW / 128), I_OUT = (D / 256) * (D / 128);
        constexpr int I_LAYER = 6 * I_GU + I_IN + I_OUT;
        static_assert(I_GU == I_DN && FF % 256 == 0, "item counts");
        __syncthreads();
        int nbuf = 0;
        for (int it = bid; it < DEPTH * I_LAYER; it += G, nbuf ^= 1) {
            const int itr = DEPTH * I_LAYER - 1 - it;
            const int l = itr / I_LAYER; int r = itr - l * I_LAYER;
            unsigned char* WL = P_WL(l);
            const float* W; int K, N, mode = 0; bf16* WT; const float* rg = nullptr;
            if (r < 3 * I_GU) { const int w = r / I_GU; r -= w * I_GU;
                if (w < 2) { W = args.in[2 + w] + (size_t)l * D * FF; K = D; N = FF; WT = (bf16*)(WL + OFF_WGU1); rg = args.in[1] + (size_t)l * D; mode = 1 + w; }
                else { W = args.in[4] + (size_t)l * FF * D; K = FF; N = D; WT = (bf16*)(WL + OFF_WD1); } }
            else if ((r -= 3 * I_GU) < 3 * I_GU) { const int w = r / I_GU; r -= w * I_GU;
                if (w < 2) { W = args.in[13 + w] + (size_t)l * D * FF; K = D; N = FF; WT = (bf16*)(WL + OFF_WGU2); rg = args.in[12] + (size_t)l * D; mode = 1 + w; }
                else { W = args.in[15] + (size_t)l * FF * D; K = FF; N = D; WT = (bf16*)(WL + OFF_WD2); } }
            else if ((r -= 3 * I_GU) < I_IN) { W = args.in[6] + (size_t)l * D * INW; K = D; N = INW; WT = (bf16*)(WL + OFF_WIN); rg = args.in[5] + (size_t)l * D; mode = 3; }
            else { r -= I_IN; W = args.in[11] + (size_t)l * D * D; K = D; N = D; WT = (bf16*)(WL + OFF_WOUT); }
            tr_item_cu(W, K, N, WT, rg, mode, lds + nbuf * TC_BUF, r, wave, lane);
        }
    }
    __threadfence(); grid.sync(); __threadfence();
    const XcdBarrier xbar = xcd_barrier_post((unsigned*)(args.ws + WS_BAR), (volatile LAS unsigned*)(lds + XB_ST_OFF), wave);

#pragma unroll 1
    for (int l = 0; l < DEPTH; ++l) {
        { WS_BASE();
          pg8::Gemm g{P_XB, (const bf16*)(P_WL(l) + OFF_WGU1), S, NGU, D}; pg8::StaticOrder so; so.init(S, NGU, Gp, bidp);
          pg8::EpiSwiglu E{P_H, FF, P_SSQX + (size_t)(3 * l + 0) * S * 8};
          pg8::gemm_phase<pg8::EpiSwiglu, pg8::StaticOrder, true, true, D, D, 0>(lds, g, so, E, wavep);
          pg8::Gemm g2{(const bf16*)(P_WL(l) + OFF_WOUT), (const bf16*)(P_WL(l) + OFF_PW), D, PW, 256}; pg8::MiniOrder mo; mo.init(D / 256, 4, 128, bidp);
          pg8::EpiBf16 E2{(bf16*)(P_WL(l) + OFF_WOUT), D};
          pg8::gemm_phase<pg8::EpiBf16, pg8::MiniOrder, true, true, 256, D, 512>(lds, g2, mo, E2, wavep); }
        GSYNC(l * 8 + 1);
        { WS_BASE();
          pg8::Gemm g{P_H, (const bf16*)(P_WL(l) + OFF_WD1), S, D, FF}; pg8::StaticOrder so; so.init(S, D, Gp, bidp);
          pg8::EpiResid E{args.in[0], args.out, P_XB, P_SSQX + (size_t)(3 * l + 1) * S * 8, 0.5f, 0, 0};
          pg8::gemm_phase<pg8::EpiResid, pg8::StaticOrder, true, true, FF, FF, 0>(lds, g, so, E, wavep); }
        GSYNC(l * 8 + 2);
        { WS_BASE();
          pg8::Gemm g{P_XB, (const bf16*)(P_WL(l) + OFF_WIN), S, INW, D}; pg8::StaticOrder so; so.init(S, INW, Gp, bidp);
          pg8::EpiWin E{P_U, P_Q, P_K, P_V, P_SSQX + (size_t)(3 * l + 1) * S * 8, P_SSQQK + (size_t)l * S * 16, args.in[7] + l * HD, args.in[8] + l * HD, P_COS, P_SIN};
          pg8::gemm_phase<pg8::EpiWin, pg8::StaticOrder, true, true, D, D, 0>(lds, g, so, E, wavep); }
        GSYNC(l * 8 + 3);
        {
            WS_BASE();
            const int lane = LANE_ID(), tid = wavep * 64 + lane, gt = bidp * NTHREADS + tid, ngt = Gp * NTHREADS;
            const float* sx = P_SSQX + (size_t)(3 * l + 1) * S * 8; const float* ssq_qk = P_SSQQK + (size_t)l * S * 16;
            bf16* Opart = P_OPART; float* Mpart = P_MPART; float* Lpart = P_LPART; bf16* A2 = P_A2; const bf16* Ub = P_U; bf16* PB = P_A2;
            for (int unit = bidp; unit < NH * (S / 256); unit += Gp) {
                const int h = unit & 7, blk = unit >> 3, s0 = blk * 256;
                LAS unsigned char* wl = lds + wavep * WLDS;
                for (int wu = wavep; wu < 24; wu += NWAVES) {
                    int p, d, r, a0, nv;
                    if (wu < 8) { p = 0; d = 1; r = 0; a0 = s0 + 32 * wu; nv = 32; }
                    else if (wu < 16) { const int j = wu - 8; p = 1; d = 4; r = j >> 1; a0 = (s0 >> 2) + 32 * (j & 1); nv = 32; }
                    else { p = 2; d = 16; r = (blk & 1) * 8 + (wu - 16); a0 = (s0 & ~511) >> 4; nv = 32; }
                    attn_wave_unit(wl, P_Q, P_K, P_V, sx, ssq_qk, Opart, Mpart, Lpart, h, p, d, r, a0, nv, lane);
                }
                {
                    asm volatile("s_waitcnt vmcnt(0)" ::: "memory");
                    __syncthreads();
                    if (wavep == 0 && lane == 0) {
                        unsigned* flg = (unsigned*)(ws + WS_BAR) + 4096 + l * 256;
                        __hip_atomic_store(flg + unit, 1u, __ATOMIC_RELAXED, __HIP_MEMORY_SCOPE_AGENT);
                        unsigned spins = 0;
                        while (__hip_atomic_load(flg + (unit ^ 8), __ATOMIC_RELAXED, __HIP_MEMORY_SCOPE_AGENT) == 0u) { __builtin_amdgcn_s_sleep(1); if (++spins > (1u << 20)) break; }
                        __builtin_amdgcn_fence(__ATOMIC_ACQUIRE, "agent");
                        asm volatile("s_waitcnt vmcnt(0)" ::: "memory");
                    }
                }
                __syncthreads();
                {
                    LAS f32x4* mw = (LAS f32x4*)lds;
                    if (tid < 256) { const int pos = s0 + tid;
                        const float m0 = Mpart[((size_t)0 * S + pos) * 8 + h], m1 = Mpart[((size_t)1 * S + pos) * 8 + h], m2 = Mpart[((size_t)2 * S + pos) * 8 + h];
                        const float l0 = Lpart[((size_t)0 * S + pos) * 8 + h], l1 = Lpart[((size_t)1 * S + pos) * 8 + h], l2 = Lpart[((size_t)2 * S + pos) * 8 + h];
                        const float mm = fmaxf(m0, fmaxf(m1, m2));
                        const float w0 = exp2f(m0 - mm), w1 = exp2f(m1 - mm), w2 = exp2f(m2 - mm);
                        const float inv = 1.0f / (w0 * l0 + w1 * l1 + w2 * l2);
                        mw[tid] = (f32x4){w0 * inv, w1 * inv, w2 * inv, 0.f}; }
                    __syncthreads();
#pragma unroll 4
                    for (int it = tid; it < 256 * 16; it += NTHREADS) {
                        const int pr = it >> 4, pos = s0 + pr, c8 = it & 15;
                        const u32x4 b0 = *(const u32x4*)(Opart + ((size_t)0 * S + pos) * 1024 + h * 128 + 8 * c8);
                        const u32x4 b1 = *(const u32x4*)(Opart + ((size_t)1 * S + pos) * 1024 + h * 128 + 8 * c8);
                        const u32x4 b2 = *(const u32x4*)(Opart + ((size_t)2 * S + pos) * 1024 + h * 128 + 8 * c8);
                        const f32x4 w = mw[pr];
                        u32x4 pk;
#pragma unroll
                        for (int e = 0; e < 4; ++e) {
                            const float lo = __uint_as_float(b0[e] << 16) * w[0] + __uint_as_float(b1[e] << 16) * w[1] + __uint_as_float(b2[e] << 16) * w[2];
                            const float hi = __uint_as_float(b0[e] & 0xffff0000u) * w[0] + __uint_as_float(b1[e] & 0xffff0000u) * w[1] + __uint_as_float(b2[e] & 0xffff0000u) * w[2];
                            pk[e] = pk2(lo, hi); }
                        asm volatile("global_store_dwordx4 %0, %1, off sc1\n\ts_nop 1" :: "v"(A2 + (size_t)pos * D + 1024 + h * 128 + 8 * c8), "v"(pk) : "memory");
                    }
                }
                __syncthreads();
            }
            for (int it = gt; it < S * 128; it += ngt) {
                const int g = it / (S * 32), rem = it - g * (S * 32), s = rem >> 5, ch = g * 32 + (rem & 31);
                const bf16* ub = Ub + ch * 8;
                if (g == 0) pooled_item<1>(ub, PB + ch * 8, s);
                else if (g == 1) pooled_item<2>(ub, PB + ch * 8, s);
                else if (g == 2) pooled_item<4>(ub, PB + ch * 8, s);
                else pooled_item<8>(ub, PB + ch * 8, s);
            }
        }
        GSYNC(l * 8 + 4);
        { WS_BASE();
          pg8::Gemm g{P_A2, (const bf16*)(P_WL(l) + OFF_WOUT), S, D, D}; pg8::StaticOrder so; so.init(S, D, Gp, bidp);
          pg8::EpiResid E{args.in[0], args.out, P_XB, P_SSQX + (size_t)(3 * l + 2) * S * 8, 1.0f, 0, 0};
          pg8::gemm_phase<pg8::EpiResid, pg8::StaticOrder, true, true, D, D, 0>(lds, g, so, E, wavep); }
        GSYNC(l * 8 + 6);
        { WS_BASE();
          pg8::Gemm g{P_XB, (const bf16*)(P_WL(l) + OFF_WGU2), S, NGU, D}; pg8::StaticOrder so; so.init(S, NGU, Gp, bidp);
          pg8::EpiSwiglu E{P_H, FF, P_SSQX + (size_t)(3 * l + 2) * S * 8};
          pg8::gemm_phase<pg8::EpiSwiglu, pg8::StaticOrder, true, true, D, D, 0>(lds, g, so, E, wavep); }
        GSYNC(l * 8 + 7);
        { WS_BASE();
          pg8::Gemm g{P_H, (const bf16*)(P_WL(l) + OFF_WD2), S, D, FF}; pg8::StaticOrder so; so.init(S, D, Gp, bidp);
          pg8::EpiResid E{args.in[0], args.out, P_XB, P_SSQX + (size_t)(3 * l + 3) * S * 8, 0.5f, 0, (l + 1 == DEPTH) ? 1 : 0};
          pg8::gemm_phase<pg8::EpiResid, pg8::StaticOrder, true, true, FF, FF, 0>(lds, g, so, E, wavep); }
        if (l + 1 < DEPTH) GSYNC(l * 8 + 8);
    }
}

extern "C" void kernel_launch(void* const* d_in, const int* in_sizes, int n_in, void* d_out, int out_size, void* d_ws, size_t ws_size, hipStream_t stream) {
    static int grid = 0;
    if (grid == 0) {
        if (n_in != 16 || ws_size < WS_END) { fprintf(stderr, "kernel_launch: need 16 inputs and >= %zu bytes of workspace (got %d, %zu)\n", (size_t)WS_END, n_in, ws_size); grid = -1; return; }
        int dev = 0, cus = 0, per_cu = 0;
        (void)hipGetDevice(&dev); (void)hipDeviceGetAttribute(&cus, hipDeviceAttributeMultiprocessorCount, dev);
        if (hipFuncSetAttribute((const void*)mega_fwd, hipFuncAttributeMaxDynamicSharedMemorySize, LDS_BYTES) != hipSuccess) { fprintf(stderr, "kernel_launch: hipFuncSetAttribute failed\n"); grid = -1; return; }
        if (hipOccupancyMaxActiveBlocksPerMultiprocessor(&per_cu, (const void*)mega_fwd, NTHREADS, LDS_BYTES) != hipSuccess || per_cu < 1) { fprintf(stderr, "kernel_launch: occupancy query says %d blocks per CU\n", per_cu); per_cu = 1; }
        (void)hipGetLastError();
        grid = cus;
    }
    if (grid < 0) return;
    Args a{};
    for (int i = 0; i < 16; ++i) a.in[i] = (const float*)d_in[i];
    a.out = (float*)d_out; a.ws = (unsigned char*)d_ws;
    void* kargs[] = {&a};
    hipError_t e = hipLaunchCooperativeKernel((const void*)mega_fwd, dim3(grid), dim3(NTHREADS), kargs, LDS_BYTES, stream);
    if (e != hipSuccess) fprintf(stderr, "kernel_launch: cooperative launch failed: %s (grid %d)\n", hipGetErrorString(e), grid);
}
```

```cpp
#include <hip/hip_runtime.h>
#include <hip/hip_cooperative_groups.h>
#include <cstdio>
#include <cstdint>
namespace cg = cooperative_groups;
namespace pg8 {
#define PG8_LAS __attribute__((address_space(3)))
typedef unsigned short bf16_t;
typedef short bf16x8 __attribute__((ext_vector_type(8)));
typedef float f32x4 __attribute__((ext_vector_type(4)));
typedef unsigned u32x4 __attribute__((ext_vector_type(4)));
typedef unsigned u32x2 __attribute__((ext_vector_type(2)));
constexpr int BM = 256, BK = 64, HALF = 128, HTB = HALF * BK * 2  , STAGE_BYTES = 8 * HTB, NXCD = 8, WGM = 8;

__host__ __device__ __forceinline__ int lds_byte(int r, int c) { const int st = (r >> 4) * 2 + (c >> 5), rr = r & 15, cc = c & 31, ob = rr * 64 + cc * 2; return st * 1024 + (ob ^ (((ob >> 9) & 1) << 5)); }
__host__ __device__ __forceinline__ void stage_rc(int b, int& R, int& C) { const int st = b / 1024, sb = b % 1024, swz = sb ^ (((sb >> 9) & 1) << 5); R = (st >> 1) * 16 + swz / 64; C = (st & 1) * 32 + (swz % 64) / 2; }
__host__ __device__ __forceinline__ int perm32(int rho) { const int n = rho >> 4, i = rho & 15; return 8 * (i >> 2) + 4 * n + (i & 3); }

struct Unit { int pm, pn; };
struct Gemm { const bf16_t* A; const bf16_t* Bt; int M, N, K; };

struct StaticOrder {
    int nM, nN, nwg, G, c;
    __host__ __device__ void init(int M, int N, int G_, int c_) { nM = M / BM; nN = N / BM; nwg = nM * nN; G = G_; c = c_; }
    __host__ __device__ bool next(int i, Unit& u) const {
        const long L = (long)i * G + c; if (L >= nwg) return false;
        int wgid = (int)L; { const int q = nwg / NXCD, r = nwg % NXCD, xcd = wgid % NXCD, off = wgid / NXCD; wgid = (xcd < r ? xcd * (q + 1) : r * (q + 1) + (xcd - r) * q) + off; }
        const int nig = WGM * nN, gid = wgid / nig, fm = gid * WGM, gsz = (nM - fm) < WGM ? (nM - fm) : WGM;
        u.pm = fm + ((wgid % nig) % gsz); u.pn = (wgid % nig) / gsz; return true;
    }
    __device__ __forceinline__ void a_ready(const Unit&) const {}
    __device__ __forceinline__ void done(const Unit&) const {}
};

struct MiniOrder {
    int nN, n, c;
    __host__ __device__ void init(int nM_, int nN_, int c0, int c_) { nN = nN_; n = nM_ * nN_; c = c_ - c0; }
    __host__ __device__ bool next(int i, Unit& u) const { if (i != 0 || c < 0 || c >= n) return false; u.pm = c / nN; u.pn = c - u.pm * nN; return true; }
    __device__ __forceinline__ void a_ready(const Unit&) const {}
    __device__ __forceinline__ void done(const Unit&) const {}
};

__device__ __forceinline__ unsigned cvt_pk_bf16(float lo, float hi) { unsigned r; asm volatile("v_cvt_pk_bf16_f32 %0, %1, %2" : "=v"(r) : "v"(lo), "v"(hi)); return r; }

constexpr float EPS = 1e-6f;
typedef unsigned long long u64;
__device__ __forceinline__ void ssq_add(u64* p, float v) { atomicAdd(p, (u64)(v * 1048576.0f + 0.5f)); }
__device__ __forceinline__ float ssq_get(const u64* p) { return (float)(*p) * (1.0f / 1048576.0f); }
__device__ __forceinline__ float part8(const float* p) { const f32x4 a = *(const f32x4*)p, b = *(const f32x4*)(p + 4); return ((a[0] + a[1]) + (a[2] + a[3])) + ((b[0] + b[1]) + (b[2] + b[3])); }


struct EpiBf16 {
    static constexpr bool PERM = true, AFTER_DRAIN = false, HAS_INIT = false, HAS_ACC_INIT = false, HAS_XT = false;
    bf16_t* O; int ldc;
    __device__ __forceinline__ void operator()(const f32x4 (&acc)[2][2][4][2], const Unit& u, int wr, int wc, int fr, int fq) const {
        const int row0 = u.pm * BM + wr * 64 + fr, col0 = u.pn * BM + wc * 32 + 8 * fq;
#pragma unroll
        for (int ai = 0; ai < 2; ++ai)
#pragma unroll
            for (int m = 0; m < 4; ++m) { bf16_t* rowp = O + (size_t)(row0 + ai * HALF + m * 16) * ldc + col0;
#pragma unroll
                for (int bj = 0; bj < 2; ++bj) { const f32x4 v0 = acc[ai][bj][m][0], v1 = acc[ai][bj][m][1];
                    u32x4 w; w.x = cvt_pk_bf16(v0[0], v0[1]); w.y = cvt_pk_bf16(v0[2], v0[3]); w.z = cvt_pk_bf16(v1[0], v1[1]); w.w = cvt_pk_bf16(v1[2], v1[3]);
                    *(u32x4*)(rowp + bj * HALF) = w; } }
    }
};

struct EpiSwiglu {
    static constexpr bool PERM = true, AFTER_DRAIN = false, HAS_INIT = true, HAS_ACC_INIT = false, HAS_XT = false;
    bf16_t* H; int ldh; const float* ssq;
    template <class Sched> __device__ __forceinline__ void phase_init(const Sched& S, PG8_LAS float* tab, int tid) const {
        Unit u;
        for (int i = 0; S.next(i, u); ++i)
            if (tid < 256) tab[i * 256 + tid] = __builtin_amdgcn_rsqf(part8(ssq + (size_t)(u.pm * BM + tid) * 8) * (1.0f / 2048.0f) + EPS);
    }
    __device__ __forceinline__ void operator()(const f32x4 (&acc)[2][2][4][2], const Unit& u, int wr, int wc, int fr, int fq, const PG8_LAS float* tab) const {
        const int row0 = u.pm * BM + wr * 64 + fr, col0 = u.pn * HALF + wc * 32 + 8 * fq;
#pragma unroll
        for (int ai = 0; ai < 2; ++ai)
#pragma unroll
            for (int m = 0; m < 4; ++m) { const int row = row0 + ai * HALF + m * 16;
                const float rs = tab[ai * HALF + wr * 64 + m * 16 + fr];
                float hv[8];
#pragma unroll
                for (int n = 0; n < 2; ++n)
#pragma unroll
                    for (int j = 0; j < 4; ++j) { const float g = acc[ai][0][m][n][j] * rs, up = acc[ai][1][m][n][j] * rs;
                        const float e = __builtin_amdgcn_exp2f(g * -1.4426950408889634f);
                        hv[4 * n + j] = g * up * __builtin_amdgcn_rcpf(1.0f + e); }
                u32x4 w; w.x = cvt_pk_bf16(hv[0], hv[1]); w.y = cvt_pk_bf16(hv[2], hv[3]); w.z = cvt_pk_bf16(hv[4], hv[5]); w.w = cvt_pk_bf16(hv[6], hv[7]);
                *(u32x4*)(H + (size_t)row * ldh + col0) = w; }
    }
};

struct EpiResid {
    static constexpr bool PERM = true, AFTER_DRAIN = false, HAS_INIT = false, HAS_ACC_INIT = true, HAS_XT = true;
    const float* xin; float* xout; bf16_t* xb; float* ssq_next; float f; int in_f32, out_f32;
    __device__ __forceinline__ void init_acc(f32x4 (&acc)[2][2][4][2], const Unit& u, int wr, int wc, int fr, int fq) const {
        const int row0 = u.pm * BM + wr * 64 + fr, col0 = u.pn * BM + wc * 32 + 8 * fq; const float rf = 1.0f / f;
#pragma unroll
        for (int ai = 0; ai < 2; ++ai)
#pragma unroll
            for (int m = 0; m < 4; ++m)
#pragma unroll
                for (int bj = 0; bj < 2; ++bj) { const size_t o2 = (size_t)(row0 + ai * HALF + m * 16) * 2048 + col0 + bj * HALF;
                    if (in_f32) { acc[ai][bj][m][0] = *(const f32x4*)(xin + o2) * rf; acc[ai][bj][m][1] = *(const f32x4*)(xin + o2 + 4) * rf; }
                    else { const u32x4 w = *(const u32x4*)(xb + o2);
                        acc[ai][bj][m][0] = (f32x4){__uint_as_float(w.x << 16), __uint_as_float(w.x & 0xffff0000u), __uint_as_float(w.y << 16), __uint_as_float(w.y & 0xffff0000u)} * rf;
                        acc[ai][bj][m][1] = (f32x4){__uint_as_float(w.z << 16), __uint_as_float(w.z & 0xffff0000u), __uint_as_float(w.w << 16), __uint_as_float(w.w & 0xffff0000u)} * rf; } }
    }
    __device__ __forceinline__ void operator()(const f32x4 (&acc)[2][2][4][2], const Unit& u, int wr, int wc, int fr, int fq, PG8_LAS float* xt) const {
        const int row0 = u.pm * BM + wr * 64 + fr, col0 = u.pn * BM + wc * 32 + 8 * fq;
#pragma unroll
        for (int ai = 0; ai < 2; ++ai)
#pragma unroll
            for (int m = 0; m < 4; ++m) { const int row = row0 + ai * HALF + m * 16; const size_t off = (size_t)row * 2048 + col0; float s = 0.f;
#pragma unroll
                for (int bj = 0; bj < 2; ++bj) { const size_t o2 = off + bj * HALF;
                    f32x4 x0 = acc[ai][bj][m][0] * f, x1 = acc[ai][bj][m][1] * f;
                    if (out_f32) { *(f32x4*)(xout + o2) = x0; *(f32x4*)(xout + o2 + 4) = x1; }
                    else { u32x4 w; w.x = cvt_pk_bf16(x0[0], x0[1]); w.y = cvt_pk_bf16(x0[2], x0[3]); w.z = cvt_pk_bf16(x1[0], x1[1]); w.w = cvt_pk_bf16(x1[2], x1[3]);
                        asm volatile("global_store_dwordx4 %0, %1, off sc1\n\ts_nop 1" :: "v"(xb + o2), "v"(w) : "memory");
                        x0 = (f32x4){__uint_as_float(w.x << 16), __uint_as_float(w.x & 0xffff0000u), __uint_as_float(w.y << 16), __uint_as_float(w.y & 0xffff0000u)};
                        x1 = (f32x4){__uint_as_float(w.z << 16), __uint_as_float(w.z & 0xffff0000u), __uint_as_float(w.w << 16), __uint_as_float(w.w & 0xffff0000u)}; }
                    s += (x0[0] * x0[0] + x0[1] * x0[1]) + (x0[2] * x0[2] + x0[3] * x0[3]) + (x1[0] * x1[0] + x1[1] * x1[1]) + (x1[2] * x1[2] + x1[3] * x1[3]); }
                s += __shfl_xor(s, 16); s += __shfl_xor(s, 32);
                if (fq == 0) xt[(ai * HALF + wr * 64 + m * 16 + fr) * 4 + wc] = s; }
        asm volatile("s_waitcnt lgkmcnt(0)" ::: "memory"); __builtin_amdgcn_s_barrier(); asm volatile("" ::: "memory");
        const int tid = (wr * 4 + wc) * 64 + fq * 16 + fr;
        if (tid < 256) { const f32x4 p = *(const PG8_LAS f32x4*)(xt + tid * 4); ssq_next[(size_t)(u.pm * BM + tid) * 8 + u.pn] = (p[0] + p[1]) + (p[2] + p[3]); }
    }
};

struct EpiWin {
    static constexpr bool PERM = false, AFTER_DRAIN = false, HAS_INIT = false, HAS_ACC_INIT = false, HAS_XT = true;
    bf16_t *U, *Q, *Kb, *V; const float* ssq; float* ssq_qk; const float *qg, *kg; const float *cosT, *sinT;
    __device__ __forceinline__ void operator()(const f32x4 (&acc)[2][2][4][2], const Unit& u, int wr, int wc, int fr, int fq, PG8_LAS float* xt) const {
        const int row0 = u.pm * BM + wr * 64 + fr; const int pn = u.pn;
        if (pn < 4 || pn >= 12) {
            bf16_t* O = (pn < 4) ? U : V; const int col0 = (pn & 3) * BM + wc * 32 + 8 * fq;
#pragma unroll
            for (int ai = 0; ai < 2; ++ai)
#pragma unroll
                for (int m = 0; m < 4; ++m) { const int row = row0 + ai * HALF + m * 16;
                    const float rs = __builtin_amdgcn_rsqf(part8(ssq + (size_t)row * 8) * (1.0f / 2048.0f) + EPS);
                    bf16_t* rowp = O + (size_t)row * 1024 + col0;
#pragma unroll
                    for (int bj = 0; bj < 2; ++bj) { const f32x4 v0 = acc[ai][bj][m][0] * rs, v1 = acc[ai][bj][m][1] * rs;
                        u32x4 w; w.x = cvt_pk_bf16(v0[0], v0[1]); w.y = cvt_pk_bf16(v0[2], v0[3]); w.z = cvt_pk_bf16(v1[0], v1[1]); w.w = cvt_pk_bf16(v1[2], v1[3]);
                        *(u32x4*)(rowp + bj * HALF) = w; } }
        } else {
            const bool isq = pn < 8; bf16_t* O = isq ? Q : Kb; const float* gain = isq ? qg : kg;
            const int d1 = 16 * wc + 4 * fq;
            const f32x4 g1 = *(const f32x4*)(gain + d1), g2 = *(const f32x4*)(gain + d1 + 64);
#pragma unroll
            for (int ai = 0; ai < 2; ++ai)
#pragma unroll
                for (int m = 0; m < 4; ++m) { const int row = row0 + ai * HALF + m * 16;
                    const f32x4 cs = *(const f32x4*)(cosT + (size_t)row * 64 + d1), sn = *(const f32x4*)(sinT + (size_t)row * 64 + d1);
#pragma unroll
                    for (int bj = 0; bj < 2; ++bj) { const f32x4 x1 = acc[ai][bj][m][0], x2 = acc[ai][bj][m][1];
                        float s = (x1[0] * x1[0] + x1[1] * x1[1]) + (x1[2] * x1[2] + x1[3] * x1[3]) + (x2[0] * x2[0] + x2[1] * x2[1]) + (x2[2] * x2[2] + x2[3] * x2[3]);
                        s += __shfl_xor(s, 16); s += __shfl_xor(s, 32);
                        const int hidx = (pn - 4) * 2 + bj;
                        if (fq == 0) xt[((ai * HALF + wr * 64 + m * 16 + fr) * 2 + bj) * 4 + wc] = s;
                        const f32x4 a1 = x1 * g1, a2 = x2 * g2;
                        const f32x4 y1 = a1 * cs - a2 * sn, y2 = a2 * cs + a1 * sn;
                        u32x2 w1; w1.x = cvt_pk_bf16(y1[0], y1[1]); w1.y = cvt_pk_bf16(y1[2], y1[3]);
                        u32x2 w2; w2.x = cvt_pk_bf16(y2[0], y2[1]); w2.y = cvt_pk_bf16(y2[2], y2[3]);
                        const bool odd = (fq & 1) != 0;
                        const unsigned sx = odd ? w1.x : w2.x, sy = odd ? w1.y : w2.y;
                        const unsigned rx = (unsigned)__shfl_xor((int)sx, 16), ry = (unsigned)__shfl_xor((int)sy, 16);
                        u32x4 wv; if (odd) { wv.x = rx; wv.y = ry; wv.z = w2.x; wv.w = w2.y; } else { wv.x = w1.x; wv.y = w1.y; wv.z = rx; wv.w = ry; }
                        bf16_t* p = O + (size_t)row * 1024 + (hidx & 7) * 128 + (odd ? (64 + d1 - 4) : d1);
                        *(u32x4*)p = wv; } }
            asm volatile("s_waitcnt lgkmcnt(0)" ::: "memory"); __builtin_amdgcn_s_barrier(); asm volatile("" ::: "memory");
            const int tid = (wr * 4 + wc) * 64 + fq * 16 + fr;
            { const f32x4 pq = *(const PG8_LAS f32x4*)(xt + tid * 4); ssq_qk[(size_t)(u.pm * BM + (tid >> 1)) * 16 + (pn - 4) * 2 + (tid & 1)] = (pq[0] + pq[1]) + (pq[2] + pq[3]); }
        }
    }
};

template <class Epi, class Sched, bool ALIGN_EPI, bool SP2, int KK, int LDA, int APN>
__device__ __forceinline__ void gemm_phase(PG8_LAS unsigned char* lds, const Gemm g, const Sched& S, const Epi& E, const int wid) {
    int lane_ = (int)__builtin_amdgcn_mbcnt_hi(~0u, __builtin_amdgcn_mbcnt_lo(~0u, 0u)); asm volatile("" : "+v"(lane_));
    const int lane = lane_, tid = wid * 64 + lane, wr = wid >> 2, wc = wid & 3, fr = lane & 15, fq = lane >> 4;
    constexpr int K = KK, nt = K / BK;
    unsigned voffA[2], voffB[2];
#pragma unroll
    for (int i = 0; i < 2; ++i) { int R, C; stage_rc(tid * 16 + i * 8192, R, C); const int Rb = Epi::PERM ? ((R & ~31) + perm32(R & 31)) : R;
        voffA[i] = (unsigned)(R * LDA + C) * 2u; voffB[i] = (unsigned)(Rb * K + C) * 2u; }
    const size_t kstep = (size_t)(BK * 2);
    const size_t hstep = (size_t)HALF * K * 2;
    const size_t tstep = 2 * hstep;
    const size_t hstepA = (size_t)HALF * LDA * 2, tstepA = 2 * hstepA;
    const unsigned ldsw = (unsigned)wid * 1024u;
    const int aoff = lds_byte(wr * 64 + fr, fq * 8), boff = lds_byte(wc * 32 + fr, fq * 8);
#define PG8_SA(b, h) (((b) * 2 + (h)) * HTB)
#define PG8_SB(b, h) ((4 + (b) * 2 + (h)) * HTB)
#define PG8_STAGE(bufoff, gbase, voff) do { _Pragma("unroll") for (int _i = 0; _i < 2; ++_i) \
        __builtin_amdgcn_global_load_lds((const unsigned*)((const char*)(gbase) + (voff)[_i]), (PG8_LAS unsigned*)(lds + (bufoff) + ldsw + _i * 8192), 16, 0, 0); } while (0)
#define PG8_LDA(dst, b, h) do { _Pragma("unroll") for (int m = 0; m < 4; ++m) _Pragma("unroll") for (int k = 0; k < 2; ++k) dst[m][k] = *(const PG8_LAS bf16x8*)(lds + PG8_SA(b, h) + aoff + m * 2048 + k * 1024); } while (0)
#define PG8_LDB(dst, b, h) do { _Pragma("unroll") for (int n = 0; n < 2; ++n) _Pragma("unroll") for (int k = 0; k < 2; ++k) dst[n][k] = *(const PG8_LAS bf16x8*)(lds + PG8_SB(b, h) + boff + n * 2048 + k * 1024); } while (0)
#define PG8_MMA(ai, bj, At, Bt) do { __builtin_amdgcn_s_setprio(1); _Pragma("unroll") for (int m = 0; m < 4; ++m) _Pragma("unroll") for (int n = 0; n < 2; ++n) _Pragma("unroll") for (int k = 0; k < 2; ++k) \
        acc[ai][bj][m][n] = __builtin_amdgcn_mfma_f32_16x16x32_bf16(Bt[n][k], At[m][k], acc[ai][bj][m][n], 0, 0, 0); __builtin_amdgcn_s_setprio(0); } while (0)
#define PG8_WAIT_V(n) asm volatile("s_waitcnt vmcnt(" #n ")" ::: "memory")
#define PG8_WAIT_L(n) asm volatile("s_waitcnt lgkmcnt(" #n ")" ::: "memory")
#define PG8_BAR __builtin_amdgcn_s_barrier()
#define PG8_SCHED __builtin_amdgcn_sched_barrier(0)
    Unit cur, nxt; int ui = 0;
    if (!S.next(0, cur)) return;
    PG8_LAS float* etab = (PG8_LAS float*)(lds + STAGE_BYTES);
    if constexpr (Epi::HAS_INIT) { E.phase_init(S, etab, tid); asm volatile("s_waitcnt vmcnt(0) lgkmcnt(0)" ::: "memory"); __builtin_amdgcn_s_barrier(); asm volatile("" ::: "memory"); }
    f32x4 acc[2][2][4][2];
#pragma unroll
    for (int a = 0; a < 2; ++a)
#pragma unroll
        for (int b = 0; b < 2; ++b)
#pragma unroll
            for (int m = 0; m < 4; ++m)
#pragma unroll
                for (int n = 0; n < 2; ++n) acc[a][b][m][n] = (f32x4){0.f, 0.f, 0.f, 0.f};
    if constexpr (Epi::HAS_ACC_INIT) E.init_acc(acc, cur, wr, wc, fr, fq);
    bf16x8 At[4][2], B0[2][2], B1[2][2];
    const char* cA = (const char*)g.A + (size_t)cur.pm * tstepA + (size_t)cur.pn * APN; const char* cB = (const char*)g.Bt + (size_t)cur.pn * tstep;
    S.a_ready(cur);
    if constexpr (SP2) {
        PG8_STAGE(PG8_SB(0, 0), cB, voffB); PG8_STAGE(PG8_SB(0, 1), cB + hstep, voffB); PG8_STAGE(PG8_SA(0, 0), cA, voffA); PG8_STAGE(PG8_SA(0, 1), cA + hstepA, voffA);
        if (wr == 1) PG8_BAR;
        PG8_WAIT_V(2); PG8_BAR;
        PG8_STAGE(PG8_SB(1, 0), cB + kstep, voffB); PG8_STAGE(PG8_SA(1, 0), cA + kstep, voffA); PG8_STAGE(PG8_SB(1, 1), cB + hstep + kstep, voffB);
        PG8_WAIT_V(6); PG8_BAR;
    } else {
        PG8_STAGE(PG8_SB(0, 0), cB, voffB); PG8_STAGE(PG8_SA(0, 0), cA, voffA); PG8_STAGE(PG8_SB(0, 1), cB + hstep, voffB); PG8_STAGE(PG8_SA(0, 1), cA + hstepA, voffA);
        if (wr == 1) PG8_BAR;
        PG8_WAIT_V(4); PG8_BAR;
        PG8_STAGE(PG8_SB(1, 0), cB + kstep, voffB); PG8_STAGE(PG8_SA(1, 0), cA + kstep, voffA); PG8_STAGE(PG8_SB(1, 1), cB + hstep + kstep, voffB);
        PG8_WAIT_V(6); PG8_BAR;
    }
    for (;;) {
        const bool has_next = S.next(ui + 1, nxt);
        const char* nA = has_next ? (const char*)g.A + (size_t)nxt.pm * tstepA + (size_t)nxt.pn * APN : cA; const char* nB = has_next ? (const char*)g.Bt + (size_t)nxt.pn * tstep : cB;
#pragma unroll 1
        for (int t = 0; t < nt; t += 2) {
            const bool last = (t == nt - 2);
            const char* a1 = cA + (size_t)(t + 1) * kstep;
            const char* a2 = last ? nA : cA + (size_t)(t + 2) * kstep; const char* b2 = last ? nB : cB + (size_t)(t + 2) * kstep;
            const char* a3 = a2 + kstep; const char* b3 = b2 + kstep;
            if (last && has_next) S.a_ready(nxt);
            if constexpr (SP2) {
            PG8_LDB(B0, 0, 0); PG8_LDB(B1, 0, 1); PG8_SCHED; PG8_LDA(At, 0, 0); PG8_STAGE(PG8_SA(1, 1), a1 + hstepA, voffA);
            PG8_WAIT_V(8); PG8_WAIT_L(0); PG8_BAR; PG8_MMA(0, 0, At, B0); PG8_MMA(0, 1, At, B1); PG8_BAR; PG8_SCHED;
            PG8_LDA(At, 0, 1); PG8_STAGE(PG8_SB(0, 0), b2, voffB); PG8_STAGE(PG8_SB(0, 1), b2 + hstep, voffB); PG8_STAGE(PG8_SA(0, 0), a2, voffA);
            PG8_WAIT_V(8); PG8_WAIT_L(0); PG8_BAR; PG8_MMA(1, 0, At, B0); PG8_MMA(1, 1, At, B1); PG8_BAR; PG8_SCHED;
            PG8_LDB(B0, 1, 0); PG8_LDB(B1, 1, 1); PG8_SCHED; PG8_LDA(At, 1, 0); PG8_STAGE(PG8_SA(0, 1), a2 + hstepA, voffA);
            PG8_WAIT_V(8); PG8_WAIT_L(0); PG8_BAR; PG8_MMA(0, 0, At, B0); PG8_MMA(0, 1, At, B1); PG8_BAR; PG8_SCHED;
            PG8_LDA(At, 1, 1); PG8_STAGE(PG8_SB(1, 0), b3, voffB); PG8_STAGE(PG8_SB(1, 1), b3 + hstep, voffB); PG8_STAGE(PG8_SA(1, 0), a3, voffA);
            PG8_WAIT_V(8); PG8_WAIT_L(0); PG8_BAR; PG8_MMA(1, 0, At, B0); PG8_MMA(1, 1, At, B1); PG8_BAR; PG8_SCHED;
            } else {
            PG8_LDB(B0, 0, 0); PG8_SCHED; PG8_LDA(At, 0, 0); PG8_STAGE(PG8_SA(1, 1), a1 + hstepA, voffA);
            PG8_WAIT_L(8); PG8_BAR; PG8_WAIT_L(0); PG8_MMA(0, 0, At, B0); PG8_BAR; PG8_SCHED;
            PG8_LDB(B1, 0, 1); PG8_STAGE(PG8_SB(0, 0), b2, voffB);
            PG8_BAR; PG8_WAIT_L(0); PG8_MMA(0, 1, At, B1); PG8_BAR;
            PG8_LDA(At, 0, 1); PG8_STAGE(PG8_SA(0, 0), a2, voffA);
            PG8_BAR; PG8_WAIT_L(0); PG8_MMA(1, 0, At, B0); PG8_BAR; PG8_SCHED;
            PG8_STAGE(PG8_SB(0, 1), b2 + hstep, voffB);
            PG8_WAIT_V(6); PG8_BAR; PG8_MMA(1, 1, At, B1); PG8_BAR;
            PG8_LDB(B0, 1, 0); PG8_SCHED; PG8_LDA(At, 1, 0); PG8_STAGE(PG8_SA(0, 1), a2 + hstepA, voffA);
            PG8_WAIT_L(8); PG8_BAR; PG8_WAIT_L(0); PG8_MMA(0, 0, At, B0); PG8_BAR; PG8_SCHED;
            PG8_LDB(B1, 1, 1); PG8_STAGE(PG8_SB(1, 0), b3, voffB);
            PG8_BAR; PG8_WAIT_L(0); PG8_MMA(0, 1, At, B1); PG8_BAR;
            PG8_LDA(At, 1, 1); PG8_STAGE(PG8_SA(1, 0), a3, voffA);
            PG8_BAR; PG8_WAIT_L(0); PG8_MMA(1, 0, At, B0); PG8_BAR; PG8_SCHED;
            PG8_STAGE(PG8_SB(1, 1), b3 + hstep, voffB);
            PG8_WAIT_V(6); PG8_BAR; PG8_MMA(1, 1, At, B1); PG8_BAR;
            }
        }
        if constexpr (ALIGN_EPI) { if (wr == 0) PG8_BAR; }
        if constexpr (!Epi::AFTER_DRAIN) { if constexpr (Epi::HAS_INIT) E(acc, cur, wr, wc, fr, fq, etab + ui * 256); else if constexpr (Epi::HAS_XT) E(acc, cur, wr, wc, fr, fq, etab); else E(acc, cur, wr, wc, fr, fq); S.done(cur); }
        if (!has_next) break;
#pragma unroll
        for (int a = 0; a < 2; ++a)
#pragma unroll
            for (int b = 0; b < 2; ++b)
#pragma unroll
                for (int m = 0; m < 4; ++m)
#pragma unroll
                    for (int n = 0; n < 2; ++n) acc[a][b][m][n] = (f32x4){0.f, 0.f, 0.f, 0.f};
        if constexpr (Epi::HAS_ACC_INIT) E.init_acc(acc, nxt, wr, wc, fr, fq);
        cur = nxt; cA = nA; cB = nB; ++ui;
        if constexpr (ALIGN_EPI) { if (wr == 1) PG8_BAR; }
    }
    PG8_WAIT_V(0);
    if constexpr (!ALIGN_EPI) { if (wr == 0) PG8_BAR; }
    PG8_BAR;
    if constexpr (Epi::AFTER_DRAIN) { E.fused(acc, cur, wr, wc, fr, fq, lds, wid, lane); S.done(cur); }
#undef PG8_SA
#undef PG8_SB
#undef PG8_STAGE
#undef PG8_LDA
#undef PG8_LDB
#undef PG8_MMA
#undef PG8_WAIT_V
#undef PG8_WAIT_L
#undef PG8_BAR
#undef PG8_SCHED
}
}

#define LAS __attribute__((address_space(3)))
typedef unsigned short bf16;
typedef float f32x4 __attribute__((ext_vector_type(4)));
typedef float f32x16 __attribute__((ext_vector_type(16)));
typedef short bf16x8 __attribute__((ext_vector_type(8)));
typedef short s16x4 __attribute__((ext_vector_type(4)));
typedef unsigned u32x4 __attribute__((ext_vector_type(4)));
typedef unsigned u32x2 __attribute__((ext_vector_type(2)));

constexpr int S = 8192, D = 2048, FF = 5632, NGU = 2 * FF, INW = 4096, PW = 1024, NH = 8, HD = 128, DEPTH = 2;
constexpr int NWAVES = 8, NTHREADS = 512;
constexpr int LDS_BYTES = 163840;
constexpr float EPSF = 1e-6f;

constexpr size_t MiB = 1u << 20;
constexpr size_t WS_SSQX = 0;
constexpr size_t WS_BAR = 512 * 1024;
constexpr size_t WS_SSQQK = 1 * MiB;
constexpr size_t WS_ML = 3 * MiB;
constexpr size_t WS_COS = 5 * MiB, WS_SIN = 7 * MiB;
constexpr size_t WS_W = 9 * MiB;
constexpr size_t SZ_WGU = (size_t)NGU * D * 2, SZ_WD = (size_t)D * FF * 2, SZ_WIN = (size_t)INW * D * 2, SZ_WOUT = (size_t)D * D * 2, SZ_PW = (size_t)PW * 256 * 2;
constexpr size_t OFF_WGU1 = 0, OFF_WD1 = OFF_WGU1 + SZ_WGU, OFF_WIN = OFF_WD1 + SZ_WD, OFF_PW = OFF_WIN + SZ_WIN, OFF_WOUT = OFF_PW + SZ_PW, OFF_WGU2 = OFF_WOUT + SZ_WOUT, OFF_WD2 = OFF_WGU2 + SZ_WGU, SZ_LAYER = OFF_WD2 + SZ_WD;
constexpr size_t WS_XB = WS_W + DEPTH * SZ_LAYER;
constexpr size_t WS_A2 = WS_XB + (size_t)S * D * 2;
constexpr size_t WS_H = WS_A2 + (size_t)S * D * 2;
constexpr size_t WS_OPART = WS_H + (size_t)S * FF * 2;
constexpr size_t WS_PART = WS_OPART + (size_t)3 * S * 1024 * 4;
constexpr size_t WS_END = WS_PART + 2 * MiB;

__device__ __forceinline__ float bf2f(unsigned short b) { return __uint_as_float((unsigned)b << 16); }
__device__ __forceinline__ unsigned f2bf(float f) { unsigned u = __float_as_uint(f); return (u + 0x7fffu + ((u >> 16) & 1u)) >> 16; }
__device__ __forceinline__ unsigned pk2(float lo, float hi) { return f2bf(lo) | (f2bf(hi) << 16); }
__device__ __forceinline__ float wave_sum(float v) {
#pragma unroll
    for (int o = 1; o < 64; o <<= 1) v += __shfl_xor(v, o);
    return v;
}

__device__ __forceinline__ int row_map(int mode, int n) {
    if (mode == 0) return n;
    if (mode == 1) return (n >> 7) * 256 + (n & 127);
    if (mode == 2) return (n >> 7) * 256 + 128 + (n & 127);
    if (n < 1024 || n >= 3072) { const int c = n & 31; return (n & ~31) + 16 * ((c >> 2) & 1) + 4 * (c >> 3) + (c & 3); }
    const int dd = (n - 1024) & 127; return (n - dd) + ((((dd >> 4) & 3) << 5) | ((dd >> 6) << 4) | (dd & 15));
}
constexpr int TRP = 144;
__device__ __forceinline__ void tr_item64(const float* __restrict__ W, int K, int N, bf16* __restrict__ WT, const float* rowgain, const float* colgain, int mode, LAS unsigned char* scr, int item, int lane) {
    const int nblk = N >> 6, kb = item / nblk, nb = item - kb * nblk, k0 = 64 * kb, n0 = 64 * nb;
    const int g = lane >> 4, c = lane & 15;
    f32x4 v[16];
    const float* src = W + (size_t)(k0 + 16 * g) * N + n0 + 4 * c;
#pragma unroll
    for (int j = 0; j < 16; ++j) v[j] = __builtin_nontemporal_load((const f32x4*)(src + (size_t)j * N));
    f32x4 cg4 = (f32x4){1.f, 1.f, 1.f, 1.f};
    if (colgain) cg4 = *(const f32x4*)(colgain + n0 + 4 * c);
    if (rowgain) {
#pragma unroll
        for (int q = 0; q < 4; ++q) { const f32x4 r4 = *(const f32x4*)(rowgain + k0 + 16 * g + 4 * q);
#pragma unroll
            for (int e = 0; e < 4; ++e) v[4 * q + e] = v[4 * q + e] * r4[e]; }
    }
#pragma unroll
    for (int i = 0; i < 4; ++i) {
        u32x4 lo, hi;
        lo.x = pg8::cvt_pk_bf16(v[0][i] * cg4[i], v[1][i] * cg4[i]);   lo.y = pg8::cvt_pk_bf16(v[2][i] * cg4[i], v[3][i] * cg4[i]);
        lo.z = pg8::cvt_pk_bf16(v[4][i] * cg4[i], v[5][i] * cg4[i]);   lo.w = pg8::cvt_pk_bf16(v[6][i] * cg4[i], v[7][i] * cg4[i]);
        hi.x = pg8::cvt_pk_bf16(v[8][i] * cg4[i], v[9][i] * cg4[i]);   hi.y = pg8::cvt_pk_bf16(v[10][i] * cg4[i], v[11][i] * cg4[i]);
        hi.z = pg8::cvt_pk_bf16(v[12][i] * cg4[i], v[13][i] * cg4[i]); hi.w = pg8::cvt_pk_bf16(v[14][i] * cg4[i], v[15][i] * cg4[i]);
        LAS unsigned char* p = scr + (4 * c + i) * TRP + 32 * g;
        *(LAS u32x4*)p = lo; *(LAS u32x4*)(p + 16) = hi;
    }
    asm volatile("s_waitcnt lgkmcnt(0)" ::: "memory");
#pragma unroll
    for (int m = 0; m < 8; ++m) { const int row = 8 * m + (lane >> 3), ch = lane & 7;
        const u32x4 o = *(const LAS u32x4*)(scr + row * TRP + ch * 16);
        *(u32x4*)(WT + (size_t)row_map(mode, n0 + row) * K + k0 + 8 * ch) = o; }
    asm volatile("s_waitcnt lgkmcnt(0)" ::: "memory");
}

constexpr int TCP = 528, TC_BUF = 128 * TCP;
__device__ __forceinline__ void tr_item_cu(const float* __restrict__ W, int K, int N, bf16* __restrict__ WT, const float* rowgain, int mode, LAS unsigned char* buf, int item, int wave, int lane) {
    const int nblk = N >> 7, kb = item / nblk, nb = item - kb * nblk, k0 = 256 * kb, n0 = 128 * nb;
    const int hr = lane >> 5, c = lane & 31, kw = 32 * wave + 16 * hr;
    f32x4 v[16];
    const float* src = W + (size_t)(k0 + kw) * N + n0 + 4 * c;
#pragma unroll
    for (int j = 0; j < 16; ++j) v[j] = __builtin_nontemporal_load((const f32x4*)(src + (size_t)j * N));
    if (rowgain) {
#pragma unroll
        for (int q = 0; q < 4; ++q) { const f32x4 r4 = *(const f32x4*)(rowgain + k0 + kw + 4 * q);
#pragma unroll
            for (int e = 0; e < 4; ++e) v[4 * q + e] = v[4 * q + e] * r4[e]; }
    }
#pragma unroll
    for (int i = 0; i < 4; ++i) {
        u32x4 lo, hi;
        lo.x = pg8::cvt_pk_bf16(v[0][i], v[1][i]);   lo.y = pg8::cvt_pk_bf16(v[2][i], v[3][i]);   lo.z = pg8::cvt_pk_bf16(v[4][i], v[5][i]);   lo.w = pg8::cvt_pk_bf16(v[6][i], v[7][i]);
        hi.x = pg8::cvt_pk_bf16(v[8][i], v[9][i]);   hi.y = pg8::cvt_pk_bf16(v[10][i], v[11][i]); hi.z = pg8::cvt_pk_bf16(v[12][i], v[13][i]); hi.w = pg8::cvt_pk_bf16(v[14][i], v[15][i]);
        LAS unsigned char* p = buf + (4 * c + i) * TCP + kw * 2;
        *(LAS u32x4*)p = lo; *(LAS u32x4*)(p + 16) = hi;
    }
    __syncthreads();
#pragma unroll
    for (int m = 0; m < 8; ++m) { const int row = 16 * wave + 2 * m + hr;
        const u32x4 o = *(const LAS u32x4*)(buf + row * TCP + c * 16);
        asm volatile("global_store_dwordx4 %0, %1, off sc1\n\ts_nop 1" :: "v"(WT + (size_t)row_map(mode, n0 + row) * K + k0 + 8 * c), "v"(o) : "memory"); }
}

__device__ __forceinline__ int crow(int r, int hi) { return (r & 3) + 8 * (r >> 2) + 4 * hi; }
constexpr int VPITCH = 320, KPITCH = 272, K_OFF = 10240, CK_OFF = 18944, WLDS = 19584;
constexpr int XB_ST_OFF = 8 * WLDS + 64;
__device__ __forceinline__ void attn_wave_unit(LAS unsigned char* wl, const bf16* __restrict__ Q, const bf16* __restrict__ Kb, const bf16* __restrict__ V, const float* ssq_x, const float* ssq_qk,
                                               bf16* Opart, float* Mpart, float* Lpart, int h, int p, int d, int r, int a0, int nvalid, int lane) {
    const int L = S / d; const int qi = lane & 31, hh = lane >> 5;
    LAS float* ckl = (LAS float*)(wl + CK_OFF);
    for (int i = lane; i < 160; i += 64) {
        int ka = a0 - 64 + i; ka = ka < 0 ? 0 : (ka > L - 1 ? L - 1 : ka); const int pos = r + d * ka;
        const float rs = __builtin_amdgcn_rsqf(pg8::part8(ssq_x + (size_t)pos * 8) * (1.0f / 2048.0f) + EPSF);
        const float sk = ssq_qk[(size_t)pos * 16 + 8 + h];
        ckl[i] = rs * __builtin_amdgcn_rsqf(rs * rs * sk * (1.0f / 128.0f) + EPSF);
    }
    const int aq = (a0 + qi) > L - 1 ? L - 1 : (a0 + qi); const int qpos = r + d * aq;
    float cq;
    { const float rs = __builtin_amdgcn_rsqf(pg8::part8(ssq_x + (size_t)qpos * 8) * (1.0f / 2048.0f) + EPSF); const float sq = ssq_qk[(size_t)qpos * 16 + h];
      cq = rs * __builtin_amdgcn_rsqf(rs * rs * sq * (1.0f / 128.0f) + EPSF) * (0.08838834764831845f * 1.4426950408889634f); }
    bf16x8 qf[8];
    { const bf16* qrow = Q + (size_t)qpos * 1024 + h * 128 + 8 * hh;
#pragma unroll
      for (int ks = 0; ks < 8; ++ks) qf[ks] = *(const bf16x8*)(qrow + 16 * ks); }
    f32x16 o[4];
#pragma unroll
    for (int db = 0; db < 4; ++db)
#pragma unroll
        for (int e = 0; e < 16; ++e) o[db][e] = 0.f;
    float m_run = -1e30f, l_run = 0.f;
    asm volatile("s_waitcnt lgkmcnt(0)" ::: "memory");
    const int qa = a0 + qi;
    const int trbase = (4 * hh + ((lane & 15) >> 2)) * VPITCH + (16 * ((lane >> 4) & 1) + 4 * (lane & 3)) * 2;
    u32x4 kr[8], vr[8];
#define ATT_LOAD_KV(t_) do { _Pragma("unroll") for (int i = 0; i < 8; ++i) { int vi = a0 - 64 + 32 * (t_) + 4 * i + (lane >> 4); vi = vi < 0 ? 0 : (vi > L - 1 ? L - 1 : vi); \
        const size_t go = (size_t)(r + d * vi) * 1024 + h * 128 + (lane & 15) * 8; kr[i] = *(const u32x4*)(Kb + go); vr[i] = *(const u32x4*)(V + go); } } while (0)
    ATT_LOAD_KV(0);
    const int kfbase = K_OFF + qi * KPITCH + 16 * hh;
#pragma unroll 1
    for (int t = 0; t < 5; ++t) {
        const int kb = a0 - 64 + 32 * t;
#pragma unroll
        for (int i = 0; i < 8; ++i) { *(LAS u32x4*)(wl + K_OFF + (4 * i + (lane >> 4)) * KPITCH + (lane & 15) * 16) = kr[i];
                                      *(LAS u32x4*)(wl + (4 * i + (lane >> 4)) * VPITCH + (lane & 15) * 16) = vr[i]; }
        if (t < 4) ATT_LOAD_KV(t + 1);
        asm volatile("s_waitcnt lgkmcnt(0)" ::: "memory");
        f32x16 s, sb;
#pragma unroll
        for (int e = 0; e < 16; ++e) { s[e] = 0.f; sb[e] = 0.f; }
#pragma unroll
        for (int ks = 0; ks < 8; ks += 2) {
            const bf16x8 k0 = *(const LAS bf16x8*)(wl + kfbase + 32 * ks), k1 = *(const LAS bf16x8*)(wl + kfbase + 32 * ks + 32);
            s = __builtin_amdgcn_mfma_f32_32x32x16_bf16(k0, qf[ks], s, 0, 0, 0); sb = __builtin_amdgcn_mfma_f32_32x32x16_bf16(k1, qf[ks + 1], sb, 0, 0, 0); }
        s = s + sb;
        float mt = -INFINITY;
#pragma unroll
        for (int g4 = 0; g4 < 4; ++g4) { const f32x4 ck4 = *(const LAS f32x4*)(ckl + 32 * t + 8 * g4 + 4 * hh);
#pragma unroll
            for (int j = 0; j < 4; ++j) { const int rr = 4 * g4 + j; const int ka = kb + 8 * g4 + 4 * hh + j; const int df = ka - qa;
                const bool ok = ((unsigned)ka < (unsigned)L) & ((unsigned)(df + 64) <= 128u);
                const float v = s[rr] * (cq * ck4[j]); const float sc = ok ? v : -INFINITY; s[rr] = sc; mt = fmaxf(mt, sc); } }
        mt = fmaxf(mt, __shfl_xor(mt, 32));
        const float mn = fmaxf(m_run, mt); const float alpha = __builtin_amdgcn_exp2f(m_run - mn); m_run = mn;
        float ps = 0.f;
#pragma unroll
        for (int e = 0; e < 16; ++e) { const float pe = __builtin_amdgcn_exp2f(s[e] - mn); s[e] = pe; ps += pe; }
        l_run = l_run * alpha + ps;
#pragma unroll
        for (int db = 0; db < 4; ++db)
#pragma unroll
            for (int e = 0; e < 16; ++e) o[db][e] *= alpha;
        bf16x8 pf[2];
#pragma unroll
        for (int s2 = 0; s2 < 2; ++s2) { u32x4 w; w.x = pg8::cvt_pk_bf16(s[8 * s2 + 0], s[8 * s2 + 1]); w.y = pg8::cvt_pk_bf16(s[8 * s2 + 2], s[8 * s2 + 3]);
            w.z = pg8::cvt_pk_bf16(s[8 * s2 + 4], s[8 * s2 + 5]); w.w = pg8::cvt_pk_bf16(s[8 * s2 + 6], s[8 * s2 + 7]); pf[s2] = __builtin_bit_cast(bf16x8, w); }
        bf16x8 vf[2][4];
#pragma unroll
        for (int s2 = 0; s2 < 2; ++s2)
#pragma unroll
            for (int db = 0; db < 4; ++db) {
                const s16x4 lo = __builtin_bit_cast(s16x4, __builtin_amdgcn_ds_read_tr16_b64_v4i16((LAS s16x4*)(wl + trbase + (16 * s2) * VPITCH + db * 64)));
                const s16x4 hi = __builtin_bit_cast(s16x4, __builtin_amdgcn_ds_read_tr16_b64_v4i16((LAS s16x4*)(wl + trbase + (16 * s2 + 8) * VPITCH + db * 64)));
                vf[s2][db] = __builtin_shufflevector(lo, hi, 0, 1, 2, 3, 4, 5, 6, 7); }
#pragma unroll
        for (int s2 = 0; s2 < 2; ++s2)
#pragma unroll
            for (int db = 0; db < 4; ++db) o[db] = __builtin_amdgcn_mfma_f32_32x32x16_bf16(vf[s2][db], pf[s2], o[db], 0, 0, 0);
        asm volatile("s_waitcnt lgkmcnt(0)" ::: "memory");
    }
#undef ATT_LOAD_KV
    const float l_tot = l_run + __shfl_xor(l_run, 32);
#pragma unroll
    for (int db = 0; db < 4; ++db)
#pragma unroll
        for (int g4 = 0; g4 < 4; ++g4) { u32x2 v; v.x = pg8::cvt_pk_bf16(o[db][4 * g4 + 0], o[db][4 * g4 + 1]); v.y = pg8::cvt_pk_bf16(o[db][4 * g4 + 2], o[db][4 * g4 + 3]);
            *(LAS u32x2*)(wl + qi * KPITCH + (32 * db + 8 * g4 + 4 * hh) * 2) = v; }
    asm volatile("s_waitcnt lgkmcnt(0)" ::: "memory");
#pragma unroll
    for (int i = 0; i < 8; ++i) { const int row = 4 * i + (lane >> 4), ar = a0 + row;
        const u32x4 w = *(const LAS u32x4*)(wl + row * KPITCH + (lane & 15) * 16);
        if (row < nvalid && ar < L) { bf16* dst = Opart + ((size_t)p * S + (r + d * ar)) * 1024 + h * 128 + (lane & 15) * 8;
            if (p == 2) asm volatile("global_store_dwordx4 %0, %1, off sc1\n\ts_nop 1" :: "v"(dst), "v"(w) : "memory");
            else *(u32x4*)dst = w; } }
    if (qi < nvalid && (a0 + qi) < L && hh == 0) {
        if (p == 2) { __hip_atomic_store(Mpart + ((size_t)p * S + qpos) * 8 + h, m_run, __ATOMIC_RELAXED, __HIP_MEMORY_SCOPE_AGENT); __hip_atomic_store(Lpart + ((size_t)p * S + qpos) * 8 + h, l_tot, __ATOMIC_RELAXED, __HIP_MEMORY_SCOPE_AGENT); }
        else { Mpart[((size_t)p * S + qpos) * 8 + h] = m_run; Lpart[((size_t)p * S + qpos) * 8 + h] = l_tot; }
    }
    asm volatile("s_waitcnt lgkmcnt(0)" ::: "memory");
}

template <int HW> __device__ __forceinline__ void pooled_item(const bf16* __restrict__ ub, bf16* __restrict__ pb, int s) {
    u32x4 v[2 * HW];
#pragma unroll
    for (int j = 0; j < 2 * HW; ++j) { int t = s - HW + j; t = t < 0 ? 0 : (t > S - 1 ? S - 1 : t); v[j] = *(const u32x4*)(ub + (size_t)t * 1024); }
    float a[8];
#pragma unroll
    for (int e = 0; e < 8; ++e) a[e] = 0.f;
#pragma unroll
    for (int j = 0; j < 2 * HW; ++j) { const int t = s - HW + j; const float mk = (t >= 0 && t < S) ? 1.f : 0.f;
#pragma unroll
        for (int e = 0; e < 4; ++e) { a[2 * e] += mk * __uint_as_float(v[j][e] << 16); a[2 * e + 1] += mk * __uint_as_float(v[j][e] & 0xffff0000u); } }
    const int lo = (s - HW) < 0 ? 0 : (s - HW), hi = (s + HW) > S ? S : (s + HW);
    const float ic = 1.0f / (float)(hi - lo);
    const u32x4 c = v[HW];
    u32x4 ov;
#pragma unroll
    for (int e = 0; e < 4; ++e) ov[e] = pk2(a[2 * e] * ic - __uint_as_float(c[e] << 16), a[2 * e + 1] * ic - __uint_as_float(c[e] & 0xffff0000u));
    asm volatile("global_store_dwordx4 %0, %1, off sc1\n\ts_nop 1" :: "v"(pb + (size_t)s * D), "v"(ov) : "memory");
}

#define XB_TMO      128
#define XB_XCNT(j)  (256  + 64 * (j))
#define XB_XSUB(j)  (1280 + 64 * (j))
#define XB_XGEN(j)  (2304 + 64 * (j))
#define XB_TOP      3328
#define XB_TOPGEN   3392
#define XCD_BAR_WORDS 3456
#define XB_SPIN_CAP (1u << 18)
__device__ __forceinline__ unsigned xb_ld(unsigned* p)              { return __hip_atomic_load(p, __ATOMIC_RELAXED, __HIP_MEMORY_SCOPE_AGENT); }
__device__ __forceinline__ unsigned xb_add(unsigned* p, unsigned v) { return __hip_atomic_fetch_add(p, v, __ATOMIC_RELAXED, __HIP_MEMORY_SCOPE_AGENT); }
__device__ __forceinline__ unsigned xb_xcc_id() { return (unsigned)__builtin_amdgcn_s_getreg((3 << 11) | 20) & 0xFu; }
#define XB_SPIN(cond, bar) do { unsigned _sp = 0; while (cond) { __builtin_amdgcn_s_sleep(1); \
    if ((++_sp & 255u) == 0u) { if (xb_ld(&(bar)[XB_TMO])) break; if (_sp > XB_SPIN_CAP) { atomicAdd(&(bar)[XB_TMO], 1u); break; } } } } while (0)
struct XcdBarrier { unsigned* bar; unsigned x; volatile LAS unsigned* st; };
__device__ __forceinline__ bool xb_leader(int wave) { int l_ = (int)__builtin_amdgcn_mbcnt_hi(~0u, __builtin_amdgcn_mbcnt_lo(~0u, 0u)); asm volatile("" : "+v"(l_)); return wave == 0 && l_ == 0; }
__device__ __forceinline__ XcdBarrier xcd_barrier_post(unsigned* bar, volatile LAS unsigned* st, int wave) {
    XcdBarrier b; b.bar = bar; b.x = xb_xcc_id(); b.st = st;
    if (xb_leader(wave)) (void)xb_add(&bar[XB_XCNT(b.x)], 1u);
    return b;
}
__device__ __forceinline__ void xcd_barrier_complete(unsigned* bar, unsigned x, unsigned& nloc, unsigned& nx) {
    const unsigned G = gridDim.x * gridDim.y * gridDim.z;
    unsigned sum, cnt, mine, sp = 0u;
    for (;;) {
        sum = 0u; cnt = 0u; mine = 0u;
#pragma unroll
        for (unsigned j = 0; j < 16; ++j) { const unsigned c = xb_ld(&bar[XB_XCNT(j)]); sum += c; cnt += (c > 0u) ? 1u : 0u; mine = (j == x) ? c : mine; }
        if (sum == G) break;
        __builtin_amdgcn_s_sleep(1);
        if ((++sp & 255u) == 0u) { if (xb_ld(&bar[XB_TMO])) break; if (sp > XB_SPIN_CAP) { atomicAdd(&bar[XB_TMO], 1u); break; } }
    }
    nloc = mine > 0u ? mine : 1u; nx = cnt > 0u ? cnt : 1u;
}
__device__ __forceinline__ void xcd_barrier(const XcdBarrier& b, int wave) {
    asm volatile("s_waitcnt vmcnt(0)" ::: "memory");
    __syncthreads();
    if (xb_leader(wave)) {
        unsigned* bar = b.bar;
        __builtin_amdgcn_s_waitcnt(0);
        unsigned nloc = b.st[0], nx = b.st[1];
        if (nloc == 0u) { xcd_barrier_complete(bar, b.x, nloc, nx); b.st[0] = nloc; b.st[1] = nx; }
        const unsigned old = xb_add(&bar[XB_XSUB(b.x)], 1u);
        const unsigned gen = old / nloc;
        if (old + 1u == (gen + 1u) * nloc) {
            __builtin_amdgcn_fence(__ATOMIC_RELEASE, "agent");
            asm volatile("s_waitcnt vmcnt(0)" ::: "memory");
            const unsigned og = xb_add(&bar[XB_TOP], 1u);
            const unsigned tg = og / nx;
            if (og + 1u == (tg + 1u) * nx) xb_add(&bar[XB_TOPGEN], 1u);
            else XB_SPIN(xb_ld(&bar[XB_TOPGEN]) == tg, bar);
            __builtin_amdgcn_fence(__ATOMIC_ACQUIRE, "agent");
            xb_add(&bar[XB_XGEN(b.x)], 1u);
            asm volatile("s_waitcnt vmcnt(0)" ::: "memory");
        } else {
            XB_SPIN(xb_ld(&bar[XB_XGEN(b.x)]) == gen, bar);
            __builtin_amdgcn_fence(__ATOMIC_ACQUIRE, "agent");
            asm volatile("s_waitcnt vmcnt(0)" ::: "memory");
        }
    }
    __syncthreads();
}

struct Args { const float* in[16]; float* out; unsigned char* ws; };

#define LANE_ID() ({ int l_ = (int)__builtin_amdgcn_mbcnt_hi(~0u, __builtin_amdgcn_mbcnt_lo(~0u, 0u)); asm volatile("" : "+v"(l_)); l_; })
#define WS_BASE() unsigned char* ws = args.ws; int bidp = bid, Gp = G, wavep = wave; asm volatile("" : "+s"(ws), "+s"(bidp), "+s"(Gp), "+s"(wavep));
#define P_SSQX   ((float*)(ws + WS_PART))
#define P_SSQQK  ((float*)(ws + WS_SSQQK))
#define P_MPART  ((float*)(ws + WS_ML))
#define P_LPART  ((float*)(ws + WS_ML) + 3 * S * 8)
#define P_COS    ((float*)(ws + WS_COS))
#define P_SIN    ((float*)(ws + WS_SIN))
#define P_XB     ((bf16*)(ws + WS_XB))
#define P_A2     ((bf16*)(ws + WS_A2))
#define P_H      ((bf16*)(ws + WS_H))
#define P_U      (P_H)
#define P_Q      (P_H + (size_t)S * 1024)
#define P_K      (P_H + (size_t)2 * S * 1024)
#define P_V      (P_H + (size_t)3 * S * 1024)
#define P_PB     (P_H + (size_t)4 * S * 1024)
#define P_OPART  ((bf16*)(ws + WS_OPART))
#define P_WL(l)  (ws + WS_W + (size_t)(l) * SZ_LAYER)

__global__ void __launch_bounds__(NTHREADS, 2) mega_fwd(Args args) {
    extern __shared__ __attribute__((aligned(16))) unsigned char lds_raw[];
    cg::grid_group grid = cg::this_grid();
    LAS unsigned char* lds = (LAS unsigned char*)lds_raw;
    const int wave = __builtin_amdgcn_readfirstlane(threadIdx.x >> 6);
    const int G = gridDim.x, bid = blockIdx.x;
#define GSYNC(k) xcd_barrier(xbar, wave)

    {
        WS_BASE();
        const int lane = LANE_ID(), tid = wave * 64 + lane, gt = bid * NTHREADS + tid, ngt = G * NTHREADS, gw = bid * NWAVES + wave, ngw = G * NWAVES;
        float* ssq_x = P_SSQX; float* cosT = P_COS; float* sinT = P_SIN; bf16* XB = P_XB; const float* x_in = args.in[0];
        if (bid == 0) for (int i = tid; i < 8192; i += NTHREADS) ((unsigned*)(ws + WS_BAR))[i] = 0u;
        if (tid < 2) ((volatile LAS unsigned*)(lds + XB_ST_OFF))[tid] = 0u;
        for (int i = gt; i < S * 64; i += ngt) { const int s = i >> 6, k = i & 63;
            const float inv = exp2f(-(float)(2 * k) * (1.0f / 128.0f) * 13.287712379549449f);
            const float ang = (float)s * inv; cosT[i] = cosf(ang); sinT[i] = sinf(ang); }
        for (int row = gw; row < S; row += ngw) {
            const f32x4* xr = (const f32x4*)(x_in + (size_t)row * D) + lane; float s = 0.f;
            unsigned long long* o8 = (unsigned long long*)(XB + (size_t)row * D) + lane;
#pragma unroll
            for (int j = 0; j < 8; ++j) { const f32x4 v = xr[64 * j]; s += (v[0] * v[0] + v[1] * v[1]) + (v[2] * v[2] + v[3] * v[3]);
                o8[64 * j] = (unsigned long long)pk2(v[0], v[1]) | ((unsigned long long)pk2(v[2], v[3]) << 32); }
            s = wave_sum(s); if (lane < 8) ssq_x[(size_t)row * 8 + lane] = (lane == 0) ? s : 0.f;
        }
        LAS unsigned char* scr = lds + wave * 16384;
        for (int i = gt; i < DEPTH * 4 * 256 * 64; i += ngt) {
            const int l = i >> 16, rem = i & 65535, g = rem >> 14, c = (rem >> 6) & 255, j4 = (rem & 63) * 4;
            const f32x4 w = *(const f32x4*)(args.in[9] + (((size_t)l * 4 + g) * 256 + c) * 256 + j4); const f32x4 sc = *(const f32x4*)(args.in[10] + (size_t)l * PW + g * 256 + j4);
            u32x2 o; o.x = pk2(w[0] * sc[0], w[1] * sc[1]); o.y = pk2(w[2] * sc[2], w[3] * sc[3]);
            *(u32x2*)((bf16*)(P_WL(l) + OFF_PW) + ((size_t)g * 256 + c) * 256 + j4) = o; }
        constexpr int I_GU = (D / 256) * (FF / 128), I_DN = (FF / 256) * (D / 128), I_IN = (D / 256) * (INW / 128), I_OUT = (D / 256) * (D / 128);
        constexpr int I_LAYER = 6 * I_GU + I_IN + I_OUT;
        static_assert(I_GU == I_DN && FF % 256 == 0, "item counts");
        __syncthreads();
        int nbuf = 0;
        for (int it = bid; it < DEPTH * I_LAYER; it += G, nbuf ^= 1) {
            const int itr = DEPTH * I_LAYER - 1 - it;
            const int l = itr / I_LAYER; int r = itr - l * I_LAYER;
            unsigned char* WL = P_WL(l);
            const float* W; int K, N, mode = 0; bf16* WT; const float* rg = nullptr;
            if (r < 3 * I_GU) { const int w = r / I_GU; r -= w * I_GU;
                if (w < 2) { W = args.in[2 + w] + (size_t)l * D * FF; K = D; N = FF; WT = (bf16*)(WL + OFF_WGU1); rg = args.in[1] + (size_t)l * D; mode = 1 + w; }
                else { W = args.in[4] + (size_t)l * FF * D; K = FF; N = D; WT = (bf16*)(WL + OFF_WD1); } }
            else if ((r -= 3 * I_GU) < 3 * I_GU) { const int w = r / I_GU; r -= w * I_GU;
                if (w < 2) { W = args.in[13 + w] + (size_t)l * D * FF; K = D; N = FF; WT = (bf16*)(WL + OFF_WGU2); rg = args.in[12] + (size_t)l * D; mode = 1 + w; }
                else { W = args.in[15] + (size_t)l * FF * D; K = FF; N = D; WT = (bf16*)(WL + OFF_WD2); } }
            else if ((r -= 3 * I_GU) < I_IN) { W = args.in[6] + (size_t)l * D * INW; K = D; N = INW; WT = (bf16*)(WL + OFF_WIN); rg = args.in[5] + (size_t)l * D; mode = 3; }
            else { r -= I_IN; W = args.in[11] + (size_t)l * D * D; K = D; N = D; WT = (bf16*)(WL + OFF_WOUT); }
            tr_item_cu(W, K, N, WT, rg, mode, lds + nbuf * TC_BUF, r, wave, lane);
        }
    }
    {
        asm volatile("s_waitcnt vmcnt(0)" ::: "memory");
        __syncthreads();
        const bool ldr = xb_leader(wave);
        if (ldr) { __builtin_amdgcn_fence(__ATOMIC_RELEASE, "agent"); asm volatile("s_waitcnt vmcnt(0)" ::: "memory"); }
        grid.sync();
        if (ldr) { __builtin_amdgcn_fence(__ATOMIC_ACQUIRE, "agent"); asm volatile("s_waitcnt vmcnt(0)" ::: "memory"); }
        __syncthreads();
    }
    const XcdBarrier xbar = xcd_barrier_post((unsigned*)(args.ws + WS_BAR), (volatile LAS unsigned*)(lds + XB_ST_OFF), wave);

#pragma unroll 1
    for (int l = 0; l < DEPTH; ++l) {
        { WS_BASE();
          pg8::Gemm g{P_XB, (const bf16*)(P_WL(l) + OFF_WGU1), S, NGU, D}; pg8::StaticOrder so; so.init(S, NGU, Gp, bidp);
          pg8::EpiSwiglu E{P_H, FF, P_SSQX + (size_t)(3 * l + 0) * S * 8};
          pg8::gemm_phase<pg8::EpiSwiglu, pg8::StaticOrder, true, true, D, D, 0>(lds, g, so, E, wavep);
          pg8::Gemm g2{(const bf16*)(P_WL(l) + OFF_WOUT), (const bf16*)(P_WL(l) + OFF_PW), D, PW, 256}; pg8::MiniOrder mo; mo.init(D / 256, 4, 128, bidp);
          pg8::EpiBf16 E2{(bf16*)(P_WL(l) + OFF_WOUT), D};
          pg8::gemm_phase<pg8::EpiBf16, pg8::MiniOrder, true, true, 256, D, 512>(lds, g2, mo, E2, wavep); }
        GSYNC(l * 8 + 1);
        { WS_BASE();
          pg8::Gemm g{P_H, (const bf16*)(P_WL(l) + OFF_WD1), S, D, FF}; pg8::StaticOrder so; so.init(S, D, Gp, bidp);
          pg8::EpiResid E{args.in[0], args.out, P_XB, P_SSQX + (size_t)(3 * l + 1) * S * 8, 0.5f, 0, 0};
          pg8::gemm_phase<pg8::EpiResid, pg8::StaticOrder, true, true, FF, FF, 0>(lds, g, so, E, wavep); }
        GSYNC(l * 8 + 2);
        { WS_BASE();
          pg8::Gemm g{P_XB, (const bf16*)(P_WL(l) + OFF_WIN), S, INW, D}; pg8::StaticOrder so; so.init(S, INW, Gp, bidp);
          pg8::EpiWin E{P_U, P_Q, P_K, P_V, P_SSQX + (size_t)(3 * l + 1) * S * 8, P_SSQQK + (size_t)l * S * 16, args.in[7] + l * HD, args.in[8] + l * HD, P_COS, P_SIN};
          pg8::gemm_phase<pg8::EpiWin, pg8::StaticOrder, true, true, D, D, 0>(lds, g, so, E, wavep); }
        GSYNC(l * 8 + 3);
        {
            WS_BASE();
            const int lane = LANE_ID(), tid = wavep * 64 + lane, gt = bidp * NTHREADS + tid, ngt = Gp * NTHREADS;
            const float* sx = P_SSQX + (size_t)(3 * l + 1) * S * 8; const float* ssq_qk = P_SSQQK + (size_t)l * S * 16;
            bf16* Opart = P_OPART; float* Mpart = P_MPART; float* Lpart = P_LPART; bf16* A2 = P_A2; const bf16* Ub = P_U; bf16* PB = P_A2;
            for (int unit = bidp; unit < NH * (S / 256); unit += Gp) {
                const int h = unit & 7, blk = unit >> 3, s0 = blk * 256;
                LAS unsigned char* wl = lds + wavep * WLDS;
                for (int wu = wavep; wu < 24; wu += NWAVES) {
                    int p, d, r, a0, nv;
                    if (wu < 8) { p = 0; d = 1; r = 0; a0 = s0 + 32 * wu; nv = 32; }
                    else if (wu < 16) { const int j = wu - 8; p = 1; d = 4; r = j >> 1; a0 = (s0 >> 2) + 32 * (j & 1); nv = 32; }
                    else { p = 2; d = 16; r = (blk & 1) * 8 + (wu - 16); a0 = (s0 & ~511) >> 4; nv = 32; }
                    attn_wave_unit(wl, P_Q, P_K, P_V, sx, ssq_qk, Opart, Mpart, Lpart, h, p, d, r, a0, nv, lane);
                }
                {
                    asm volatile("s_waitcnt vmcnt(0)" ::: "memory");
                    __syncthreads();
                    if (wavep == 0 && lane == 0) {
                        unsigned* flg = (unsigned*)(ws + WS_BAR) + 4096 + l * 256;
                        __hip_atomic_store(flg + unit, 1u, __ATOMIC_RELAXED, __HIP_MEMORY_SCOPE_AGENT);
                        unsigned spins = 0;
                        while (__hip_atomic_load(flg + (unit ^ 8), __ATOMIC_RELAXED, __HIP_MEMORY_SCOPE_AGENT) == 0u) { __builtin_amdgcn_s_sleep(1); if (++spins > (1u << 20)) break; }
                        __builtin_amdgcn_fence(__ATOMIC_ACQUIRE, "agent");
                        asm volatile("s_waitcnt vmcnt(0)" ::: "memory");
                    }
                }
                __syncthreads();
                {
                    LAS f32x4* mw = (LAS f32x4*)lds;
                    if (tid < 256) { const int pos = s0 + tid;
                        const float m0 = Mpart[((size_t)0 * S + pos) * 8 + h], m1 = Mpart[((size_t)1 * S + pos) * 8 + h], m2 = Mpart[((size_t)2 * S + pos) * 8 + h];
                        const float l0 = Lpart[((size_t)0 * S + pos) * 8 + h], l1 = Lpart[((size_t)1 * S + pos) * 8 + h], l2 = Lpart[((size_t)2 * S + pos) * 8 + h];
                        const float mm = fmaxf(m0, fmaxf(m1, m2));
                        const float w0 = exp2f(m0 - mm), w1 = exp2f(m1 - mm), w2 = exp2f(m2 - mm);
                        const float inv = 1.0f / (w0 * l0 + w1 * l1 + w2 * l2);
                        mw[tid] = (f32x4){w0 * inv, w1 * inv, w2 * inv, 0.f}; }
                    __syncthreads();
#pragma unroll 4
                    for (int it = tid; it < 256 * 16; it += NTHREADS) {
                        const int pr = it >> 4, pos = s0 + pr, c8 = it & 15;
                        const u32x4 b0 = *(const u32x4*)(Opart + ((size_t)0 * S + pos) * 1024 + h * 128 + 8 * c8);
                        const u32x4 b1 = *(const u32x4*)(Opart + ((size_t)1 * S + pos) * 1024 + h * 128 + 8 * c8);
                        const u32x4 b2 = *(const u32x4*)(Opart + ((size_t)2 * S + pos) * 1024 + h * 128 + 8 * c8);
                        const f32x4 w = mw[pr];
                        u32x4 pk;
#pragma unroll
                        for (int e = 0; e < 4; ++e) {
                            const float lo = __uint_as_float(b0[e] << 16) * w[0] + __uint_as_float(b1[e] << 16) * w[1] + __uint_as_float(b2[e] << 16) * w[2];
                            const float hi = __uint_as_float(b0[e] & 0xffff0000u) * w[0] + __uint_as_float(b1[e] & 0xffff0000u) * w[1] + __uint_as_float(b2[e] & 0xffff0000u) * w[2];
                            pk[e] = pk2(lo, hi); }
                        asm volatile("global_store_dwordx4 %0, %1, off sc1\n\ts_nop 1" :: "v"(A2 + (size_t)pos * D + 1024 + h * 128 + 8 * c8), "v"(pk) : "memory");
                    }
                }
                __syncthreads();
            }
            for (int it = gt; it < S * 128; it += ngt) {
                const int g = it / (S * 32), rem = it - g * (S * 32), s = rem >> 5, ch = g * 32 + (rem & 31);
                const bf16* ub = Ub + ch * 8;
                if (g == 0) pooled_item<1>(ub, PB + ch * 8, s);
                else if (g == 1) pooled_item<2>(ub, PB + ch * 8, s);
                else if (g == 2) pooled_item<4>(ub, PB + ch * 8, s);
                else pooled_item<8>(ub, PB + ch * 8, s);
            }
        }
        GSYNC(l * 8 + 4);
        { WS_BASE();
          pg8::Gemm g{P_A2, (const bf16*)(P_WL(l) + OFF_WOUT), S, D, D}; pg8::StaticOrder so; so.init(S, D, Gp, bidp);
          pg8::EpiResid E{args.in[0], args.out, P_XB, P_SSQX + (size_t)(3 * l + 2) * S * 8, 1.0f, 0, 0};
          pg8::gemm_phase<pg8::EpiResid, pg8::StaticOrder, true, true, D, D, 0>(lds, g, so, E, wavep); }
        GSYNC(l * 8 + 6);
        { WS_BASE();
          pg8::Gemm g{P_XB, (const bf16*)(P_WL(l) + OFF_WGU2), S, NGU, D}; pg8::StaticOrder so; so.init(S, NGU, Gp, bidp);
          pg8::EpiSwiglu E{P_H, FF, P_SSQX + (size_t)(3 * l + 2) * S * 8};
          pg8::gemm_phase<pg8::EpiSwiglu, pg8::StaticOrder, true, true, D, D, 0>(lds, g, so, E, wavep); }
        GSYNC(l * 8 + 7);
        { WS_BASE();
          pg8::Gemm g{P_H, (const bf16*)(P_WL(l) + OFF_WD2), S, D, FF}; pg8::StaticOrder so; so.init(S, D, Gp, bidp);
          pg8::EpiResid E{args.in[0], args.out, P_XB, P_SSQX + (size_t)(3 * l + 3) * S * 8, 0.5f, 0, (l + 1 == DEPTH) ? 1 : 0};
          pg8::gemm_phase<pg8::EpiResid, pg8::StaticOrder, true, true, FF, FF, 0>(lds, g, so, E, wavep); }
        if (l + 1 < DEPTH) GSYNC(l * 8 + 8);
    }
}

extern "C" void kernel_launch(void* const* d_in, const int* in_sizes, int n_in, void* d_out, int out_size, void* d_ws, size_t ws_size, hipStream_t stream) {
    static int grid = 0;
    if (grid == 0) {
        if (n_in != 16 || ws_size < WS_END) { fprintf(stderr, "kernel_launch: need 16 inputs and >= %zu bytes of workspace (got %d, %zu)\n", (size_t)WS_END, n_in, ws_size); grid = -1; return; }
        int dev = 0, cus = 0, per_cu = 0;
        (void)hipGetDevice(&dev); (void)hipDeviceGetAttribute(&cus, hipDeviceAttributeMultiprocessorCount, dev);
        if (hipFuncSetAttribute((const void*)mega_fwd, hipFuncAttributeMaxDynamicSharedMemorySize, LDS_BYTES) != hipSuccess) { fprintf(stderr, "kernel_launch: hipFuncSetAttribute failed\n"); grid = -1; return; }
        if (hipOccupancyMaxActiveBlocksPerMultiprocessor(&per_cu, (const void*)mega_fwd, NTHREADS, LDS_BYTES) != hipSuccess || per_cu < 1) { fprintf(stderr, "kernel_launch: occupancy query says %d blocks per CU\n", per_cu); per_cu = 1; }
        (void)hipGetLastError();
        grid = cus;
    }
    if (grid < 0) return;
    Args a{};
    for (int i = 0; i < 16; ++i) a.in[i] = (const float*)d_in[i];
    a.out = (float*)d_out; a.ws = (unsigned char*)d_ws;
    void* kargs[] = {&a};
    hipError_t e = hipLaunchCooperativeKernel((const void*)mega_fwd, dim3(grid), dim3(NTHREADS), kargs, LDS_BYTES, stream);
    if (e != hipSuccess) fprintf(stderr, "kernel_launch: cooperative launch failed: %s (grid %d)\n", hipGetErrorString(e), grid);
}
```
